# Optimizing an MI355X kernel written in HIP

```python
import math
import jax, jax.numpy as jnp
from jax import lax
import numpy as np

D_MODEL = 1024
BATCH = 4
SEQ = 8192
DEPTH = 1

POOL_WIDTH = 512
POOL_WINDOWS = (2, 4, 8, 16)
POOL_GROUP = POOL_WIDTH // len(POOL_WINDOWS)
N_DIFF_HEADS = 4
DIFF_HEAD_DIM = 64
ATTN_WIDTH = N_DIFF_HEADS * 2 * DIFF_HEAD_DIM
QBLK = 128
N_BRANCHES = 2
IN_WIDTH = POOL_WIDTH + 3 * ATTN_WIDTH + N_BRANCHES * D_MODEL
REL_BUCKETS = 32
REL_MAX_DIST = 128
N_EXPERTS = 256
TOP_K = 8
N_EXPERT_GROUPS = 8
TOPK_GROUPS = 4
EXPERT_DIM = 256
SHARED_DIM = 256
ROUTED_SCALE = 2.5
MOE_BLK = 128
ALPHA = (2 * DEPTH) ** 0.25
BETA = (8 * DEPTH) ** -0.25
LN_EPS = 1e-5

kernel_name = "hybrid_pool_diffattn_moe_deepnorm_encoder"


def lambda_init_fn(layer_idx):
    return 0.8 - 0.6 * math.exp(-0.3 * layer_idx)


def layer_norm(x, g, b):
    xf = x.astype(jnp.float32)
    mu = jnp.mean(xf, axis=-1, keepdims=True)
    var = jnp.mean(jnp.square(xf - mu), axis=-1, keepdims=True)
    y = (xf - mu) * lax.rsqrt(var + LN_EPS) * g.astype(jnp.float32) + b.astype(jnp.float32)
    return y.astype(x.dtype)


def rms_norm(x, g):
    xf = x.astype(jnp.float32)
    y = xf * lax.rsqrt(jnp.mean(jnp.square(xf), axis=-1, keepdims=True) + LN_EPS) * g.astype(jnp.float32)
    return y.astype(x.dtype)


def t5_bucket(rel):
    half = REL_BUCKETS // 2
    max_exact = half // 2
    ret = jnp.where(rel > 0, half, 0)
    n = jnp.abs(rel)
    nf = jnp.maximum(n, 1).astype(jnp.float32)
    large = max_exact + (jnp.log(nf / max_exact) / math.log(REL_MAX_DIST / max_exact)
                         * (half - max_exact)).astype(jnp.int32)
    large = jnp.minimum(large, half - 1)
    return ret + jnp.where(n < max_exact, n, large)


def relative_distance_bias(table, S):
    rel = jnp.arange(-(S - 1), S, dtype=jnp.int32)
    return table[t5_bucket(rel)].astype(jnp.float32).T


def multiscale_pool(u, w_grp, scale):
    B, S, C = u.shape
    uf = u.astype(jnp.float32)
    cs = jnp.concatenate([jnp.zeros((B, 1, C), jnp.float32), jnp.cumsum(uf, axis=1)], axis=1)
    t = jnp.arange(S)
    means = []
    for g, w in enumerate(POOL_WINDOWS):
        lo = jnp.clip(t - w // 2, 0, S)
        hi = jnp.clip(t + w - w // 2, 0, S)
        seg = cs[:, :, g * POOL_GROUP:(g + 1) * POOL_GROUP]
        win_sum = seg[:, hi] - seg[:, lo]
        means.append(win_sum / (hi - lo).astype(jnp.float32)[None, :, None])
    pooled = (jnp.concatenate(means, axis=-1) - uf).astype(u.dtype)
    pooled = pooled.reshape(B, S, len(POOL_WINDOWS), POOL_GROUP)
    mixed = jnp.einsum('bsgc,gcd->bsgd', pooled, w_grp).reshape(B, S, C)
    return mixed * scale


def diff_attention(q, k, v, lam, dist_bias):
    B, S, H, _, hd = q.shape
    nb = S // QBLK
    qb = q.reshape(B, nb, QBLK, H, 2, hd).transpose(1, 0, 2, 3, 4, 5)
    k_pos = jnp.arange(S)
    scale = hd ** -0.5

    def block(args):
        qi, q0 = args
        logits = jnp.einsum('bqhcd,bkhcd->bhcqk', qi, k,
                            preferred_element_type=jnp.float32) * scale
        rel = k_pos[None, :] - (q0 + jnp.arange(QBLK))[:, None] + (S - 1)
        bias = dist_bias[:, rel]
        p = jax.nn.softmax(logits + bias[None, :, None], axis=-1)
        a = p[:, :, 0] - lam * p[:, :, 1]
        return jnp.einsum('bhqk,bkhe->bqhe', a.astype(v.dtype), v)

    out = lax.map(block, (qb, jnp.arange(nb, dtype=jnp.int32) * QBLK))
    return out.transpose(1, 0, 2, 3, 4).reshape(B, S, H, 2 * hd)


def mixer_sublayer(h, dist_bias, w_in, b_gate, w_pool_grp, pool_scale, w_branch_pool,
                   lambda_q1, lambda_k1, lambda_q2, lambda_k2, subln_gain, w_branch_attn,
                   w_out, ln_g, ln_b, lam_init):
    B, S, D = h.shape
    P, A = POOL_WIDTH, ATTN_WIDTH
    proj = h @ w_in
    u_pool, q, k, v, g_logits = jnp.split(proj, [P, P + A, P + 2 * A, P + 3 * A], axis=-1)
    gates = jax.nn.sigmoid((g_logits + b_gate).astype(jnp.float32)).astype(h.dtype)
    g_pool, g_attn = jnp.split(gates, N_BRANCHES, axis=-1)
    y_pool = multiscale_pool(u_pool, w_pool_grp, pool_scale) @ w_branch_pool
    q = q.reshape(B, S, N_DIFF_HEADS, 2, DIFF_HEAD_DIM)
    k = k.reshape(B, S, N_DIFF_HEADS, 2, DIFF_HEAD_DIM)
    v = v.reshape(B, S, N_DIFF_HEADS, 2 * DIFF_HEAD_DIM)
    f32 = jnp.float32
    lam = (jnp.exp(jnp.sum(lambda_q1.astype(f32) * lambda_k1.astype(f32)))
           - jnp.exp(jnp.sum(lambda_q2.astype(f32) * lambda_k2.astype(f32))) + lam_init)
    o = diff_attention(q, k, v, lam, dist_bias)
    o = rms_norm(o, subln_gain) * (1.0 - lam_init)
    y_attn = o.reshape(B, S, A) @ w_branch_attn
    y = (g_pool * y_pool + g_attn * y_attn) @ w_out
    return layer_norm(ALPHA * h + y, ln_g, ln_b)


def route(t, w_router, router_bias):
    N = t.shape[0]
    s = jax.nn.sigmoid(t.astype(jnp.float32) @ w_router.astype(jnp.float32))
    biased = s + router_bias.astype(jnp.float32)
    grp = biased.reshape(N, N_EXPERT_GROUPS, N_EXPERTS // N_EXPERT_GROUPS)
    grp_score = jnp.sum(lax.top_k(grp, 2)[0], axis=-1)
    _, gidx = lax.top_k(grp_score, TOPK_GROUPS)
    gmask = jnp.any(gidx[:, :, None] == jnp.arange(N_EXPERT_GROUPS)[None, None, :], axis=1)
    masked = jnp.where(gmask[:, :, None], grp, -jnp.inf).reshape(N, N_EXPERTS)
    _, idx = lax.top_k(masked, TOP_K)
    w = jnp.take_along_axis(s, idx, axis=1)
    w = w / jnp.sum(w, axis=-1, keepdims=True) * ROUTED_SCALE
    return idx, w


def routed_experts(t, idx, wts, w_gate, w_up, w_down):
    N, D = t.shape
    K = idx.shape[1]
    E = w_gate.shape[0]
    NK = N * K
    flat_e = idx.reshape(-1)
    flat_t = jnp.repeat(jnp.arange(N, dtype=jnp.int32), K)
    flat_w = wts.reshape(-1)
    order = jnp.argsort(flat_e)
    se, st, sw = flat_e[order], flat_t[order], flat_w[order]
    counts = jnp.bincount(flat_e, length=E)
    padded = (counts + MOE_BLK - 1) // MOE_BLK * MOE_BLK
    start = jnp.cumsum(counts) - counts
    pend = jnp.cumsum(padded)
    pstart = pend - padded
    dest = pstart[se] + (jnp.arange(NK) - start[se])
    R = (NK + E * (MOE_BLK - 1) + MOE_BLK - 1) // MOE_BLK * MOE_BLK
    nblk = R // MOE_BLK
    row_tok = jnp.full((R,), N, jnp.int32).at[dest].set(st)
    row_w = jnp.zeros((R,), t.dtype).at[dest].set(sw)
    blk_e = jnp.minimum(jnp.searchsorted(pend, jnp.arange(nblk) * MOE_BLK, side='right'), E - 1)
    t_pad = jnp.concatenate([t, jnp.zeros((1, D), t.dtype)], axis=0)

    def block(args):
        e, tok, w = args
        xb = t_pad[tok]
        hid = jax.nn.silu(xb @ w_gate[e]) * (xb @ w_up[e])
        return (hid @ w_down[e]) * w[:, None]

    out = lax.map(block, (blk_e, row_tok.reshape(nblk, MOE_BLK), row_w.reshape(nblk, MOE_BLK)))
    return jax.ops.segment_sum(out.reshape(R, D), row_tok, num_segments=N + 1)[:N]


def moe_sublayer(h, w_router, router_bias, w_exp_gate, w_exp_up, w_exp_down,
                 w_sh_gate, w_sh_up, w_sh_down, ln_g, ln_b):
    B, S, D = h.shape
    t = h.reshape(B * S, D)
    idx, wts = route(t, w_router, router_bias)
    routed = routed_experts(t, idx, wts.astype(t.dtype), w_exp_gate, w_exp_up, w_exp_down)
    shared = (jax.nn.silu(t @ w_sh_gate) * (t @ w_sh_up)) @ w_sh_down
    y = (routed + shared).reshape(B, S, D)
    return layer_norm(ALPHA * h + y, ln_g, ln_b)


def setup_inputs(seed: int = 0) -> dict:
    key = jax.random.key(seed)
    ks = jax.random.split(key, 32)
    L, D, E = DEPTH, D_MODEL, N_EXPERTS
    HD = DIFF_HEAD_DIM

    def nrm(k, shape, s):
        return jax.random.normal(k, shape, jnp.float32) * s

    return {
        "x": nrm(ks[0], (BATCH, SEQ, D), 1.0),
        "rel_bias_table": nrm(ks[1], (REL_BUCKETS, N_DIFF_HEADS), 0.5),
        "w_in": nrm(ks[2], (L, D, IN_WIDTH), D ** -0.5),
        "b_gate": nrm(ks[3], (L, N_BRANCHES * D), 0.02),
        "w_pool_grp": nrm(ks[4], (L, len(POOL_WINDOWS), POOL_GROUP, POOL_GROUP), POOL_GROUP ** -0.5),
        "pool_scale": 1.0 + nrm(ks[5], (L, POOL_WIDTH), 0.02),
        "w_branch_pool": nrm(ks[6], (L, POOL_WIDTH, D), POOL_WIDTH ** -0.5 * BETA),
        "lambda_q1": nrm(ks[7], (L, HD), 0.1),
        "lambda_k1": nrm(ks[8], (L, HD), 0.1),
        "lambda_q2": nrm(ks[9], (L, HD), 0.1),
        "lambda_k2": nrm(ks[10], (L, HD), 0.1),
        "subln_gain": 1.0 + nrm(ks[11], (L, 2 * HD), 0.02),
        "w_branch_attn": nrm(ks[12], (L, ATTN_WIDTH, D), ATTN_WIDTH ** -0.5 * BETA),
        "w_out": nrm(ks[13], (L, D, D), D ** -0.5 * BETA),
        "ln1_g": 1.0 + nrm(ks[14], (L, D), 0.02),
        "ln1_b": nrm(ks[15], (L, D), 0.02),
        "w_router": nrm(ks[16], (L, D, E), D ** -0.5),
        "router_bias": nrm(ks[17], (L, E), 0.01),
        "w_exp_gate": nrm(ks[18], (L, E, D, EXPERT_DIM), D ** -0.5),
        "w_exp_up": nrm(ks[19], (L, E, D, EXPERT_DIM), D ** -0.5),
        "w_exp_down": nrm(ks[20], (L, E, EXPERT_DIM, D), EXPERT_DIM ** -0.5 * BETA),
        "w_sh_gate": nrm(ks[21], (L, D, SHARED_DIM), D ** -0.5),
        "w_sh_up": nrm(ks[22], (L, D, SHARED_DIM), D ** -0.5),
        "w_sh_down": nrm(ks[23], (L, SHARED_DIM, D), SHARED_DIM ** -0.5 * BETA),
        "ln2_g": 1.0 + nrm(ks[24], (L, D), 0.02),
        "ln2_b": nrm(ks[25], (L, D), 0.02),
    }


def reference(x, rel_bias_table, w_in, b_gate, w_pool_grp, pool_scale, w_branch_pool,
              lambda_q1, lambda_k1, lambda_q2, lambda_k2, subln_gain, w_branch_attn, w_out,
              ln1_g, ln1_b, w_router, router_bias, w_exp_gate, w_exp_up, w_exp_down,
              w_sh_gate, w_sh_up, w_sh_down, ln2_g, ln2_b):
    S = x.shape[1]
    dist_bias = relative_distance_bias(rel_bias_table, S)
    h = x
    for i in range(DEPTH):
        h = mixer_sublayer(h, dist_bias, w_in[i], b_gate[i], w_pool_grp[i], pool_scale[i],
                           w_branch_pool[i], lambda_q1[i], lambda_k1[i], lambda_q2[i],
                           lambda_k2[i], subln_gain[i], w_branch_attn[i], w_out[i],
                           ln1_g[i], ln1_b[i], lambda_init_fn(i))
        h = moe_sublayer(h, w_router[i], router_bias[i], w_exp_gate[i], w_exp_up[i],
                         w_exp_down[i], w_sh_gate[i], w_sh_up[i], w_sh_down[i],
                         ln2_g[i], ln2_b[i])
    return h
```

```cpp
#include <hip/hip_runtime.h>
#include <hip/hip_bf16.h>
#include <cstdio>
#include <cstdint>

#define GAS __attribute__((address_space(1)))
#define LAS __attribute__((address_space(3)))
typedef unsigned short bf16;
typedef unsigned v4u __attribute__((ext_vector_type(4)));
typedef unsigned v2u __attribute__((ext_vector_type(2)));
typedef float f32x4 __attribute__((ext_vector_type(4)));
typedef float f32x2 __attribute__((ext_vector_type(2)));
typedef float f32x16 __attribute__((ext_vector_type(16)));
typedef short bf16x8 __attribute__((ext_vector_type(8)));
typedef short s16x4 __attribute__((ext_vector_type(4)));
typedef GAS unsigned gu32;
#define RLX_AGENT __ATOMIC_RELAXED, __HIP_MEMORY_SCOPE_AGENT
#define LDS_WAIT() asm volatile("s_waitcnt lgkmcnt(0)" ::: "memory")
#define VM_WAIT() asm volatile("s_waitcnt vmcnt(0)" ::: "memory")

constexpr int BATCH = 4, SEQ = 8192, DM = 1024, M = BATCH * SEQ;
constexpr int PW = 512, AW = 512, INW = 4096, NH = 4;
constexpr int NE = 256, TOPK = 8, ED = 256;
constexpr float ALPHA = 1.189207115002721f;
constexpr float LN_EPS = 1e-5f, ROUTED_SCALE = 2.5f, LAM_INIT = 0.2f;
constexpr int NTILE_MAX = 1408, RMAX = NTILE_MAX * 256;
constexpr int NWAVES = 8;
#ifndef PROBE_PH
#define PROBE_PH -1
#endif
#define DUP(k) ((k) == PROBE_PH ? 2 : 1)
constexpr float QSCALE = 0.125f * 1.4426950408889634f;

constexpr size_t MiB = 1u << 20;
constexpr size_t WS_CTL = 0, CTL_ZERO_BYTES = 1 * MiB;
constexpr size_t WS_WINT = 1 * MiB, WS_WPT = 9 * MiB, WS_WAT = 10 * MiB, WS_WOT = 11 * MiB, WS_WRT = 13 * MiB;
constexpr size_t WS_IDX = 14 * MiB, WS_TKW = 15 * MiB, WS_CNT = 16 * MiB, WS_RTOK = 17 * MiB, WS_RW = 19 * MiB, WS_RSLOT = 21 * MiB;
constexpr size_t WS_WDT = 24 * MiB;
constexpr size_t WS_H1B = 153 * MiB;
constexpr size_t WS_YSB = 217 * MiB + 4096;
constexpr size_t WS_HID = 281 * MiB;
constexpr size_t WS_WGUT = 457 * MiB;
constexpr size_t WS_OS = 457 * MiB;
constexpr size_t WS_XB = 714 * MiB;
constexpr size_t WS_U = 779 * MiB, WS_Q = 811 * MiB, WS_K = 843 * MiB, WS_V = 875 * MiB;
constexpr size_t WS_G = 281 * MiB;
constexpr size_t WS_PL = 409 * MiB;
constexpr size_t WS_ON = 907 * MiB;
constexpr size_t WS_STASH = 939 * MiB;
constexpr size_t WS_T = 153 * MiB, WS_MG = 217 * MiB + 4096;
constexpr size_t WS_Z = 779 * MiB;
constexpr size_t WS_LOG = 907 * MiB;
constexpr size_t WS_END = 971 * MiB;
constexpr int CW_TMO = 0, CW_CODE = 1, CW_BAR = 4096;

constexpr int RING_OFF = 0, RING_BYTES = 131072;
constexpr int LDSCTL_OFF = RING_BYTES, MISC_OFF = LDSCTL_OFF + 320;
constexpr int LT_TILE_E = LDSCTL_OFF + 512;
constexpr int LT_TOKS = LT_TILE_E + 3072;
constexpr int LT_NTR = LT_TOKS + 8192;
constexpr int LT_ATT = 143360;
constexpr int LDS_BYTES = 155648;
static_assert(LT_NTR + 64 <= LT_ATT && LT_ATT + 2048 + 4 * 452 * 4 + 64 <= LDS_BYTES && LDS_BYTES <= 163840, "LDS map");

__device__ __forceinline__ unsigned cvt_pk_bf16(float lo, float hi) { unsigned r; asm volatile("v_cvt_pk_bf16_f32 %0, %1, %2" : "=v"(r) : "v"(lo), "v"(hi)); return r; }
__device__ __forceinline__ float bf_lo(unsigned w) { return __uint_as_float(w << 16); }
__device__ __forceinline__ float bf_hi(unsigned w) { return __uint_as_float(w & 0xffff0000u); }
__device__ __forceinline__ float wave_sum(float v) {
#pragma unroll
    for (int o = 1; o < 64; o <<= 1) v += __shfl_xor(v, o);
    return v;
}
__device__ __forceinline__ int opaque_tid(int wave0) { int t = (wave0 << 6) | (int)__builtin_amdgcn_mbcnt_hi(~0u, __builtin_amdgcn_mbcnt_lo(~0u, 0u)); asm volatile("" : "+v"(t)); return t; }
__device__ __forceinline__ float sigmoidf_(float x) { return __builtin_amdgcn_rcpf(1.0f + __builtin_amdgcn_exp2f(-1.4426950408889634f * x)); }

namespace pg8 {
constexpr int BM = 256, BK = 64, HALF = 128, HTB = HALF * BK * 2, STAGE_BYTES = 8 * HTB, NXCD = 8, WGM = 8;
__host__ __device__ __forceinline__ int lds_byte(int r, int c) { const int st = (r >> 4) * 2 + (c >> 5), rr = r & 15, cc = c & 31, ob = rr * 64 + cc * 2; return st * 1024 + (ob ^ (((ob >> 9) & 1) << 5)); }
__host__ __device__ __forceinline__ void stage_rc(int b, int& R, int& C) { const int st = b / 1024, sb = b % 1024, swz = sb ^ (((sb >> 9) & 1) << 5); R = (st >> 1) * 16 + swz / 64; C = (st & 1) * 32 + (swz % 64) / 2; }
__host__ __device__ __forceinline__ int perm32(int rho) { const int n = rho >> 4, i = rho & 15; return 8 * (i >> 2) + 4 * n + (i & 3); }

struct Unit { int pm, pn; const char* A; const char* B; int aux, e; };

struct DenseOrder {
    int nM, nN, nwg, G, c, dup; const char* A; const char* Bt; size_t tstep;
    __device__ void init(const void* A_, const void* Bt_, int Mr, int N, int K, int G_, int c_, int dup_ = 1) { dup = dup_; A = (const char*)A_; Bt = (const char*)Bt_; nM = Mr / BM; nN = N / BM; nwg = nM * nN; G = G_; c = c_; tstep = (size_t)BM * K * 2; }
    __device__ bool next(int i, Unit& u) const {
        const long L = (long)(i / dup) * G + c; if (L >= nwg) return false;
        int wgid = (int)L; { const int q = nwg / NXCD, r = nwg % NXCD, xcd = wgid % NXCD, off = wgid / NXCD; wgid = (xcd < r ? xcd * (q + 1) : r * (q + 1) + (xcd - r) * q) + off; }
        const int nig = WGM * nN, gid = wgid / nig, fm = gid * WGM, gsz = (nM - fm) < WGM ? (nM - fm) : WGM;
        u.pm = fm + ((wgid % nig) % gsz); u.pn = (wgid % nig) / gsz; u.A = A + (size_t)u.pm * tstep; u.B = Bt + (size_t)u.pn * tstep; u.aux = 0; u.e = 0; return true;
    }
};
template <int NPN, bool GATHER> struct ExpertOrder {
    int rt0, NT, G, vcu; const LAS unsigned short* tile_e; const char* A; const char* W; size_t wstride, atile, btile; int dup;
    __device__ int nreg() const { return (NT - rt0) / G; }
    __device__ int local(int j) const { const int nr = nreg(); if (j < nr) return rt0 + vcu + j * G;
        const int ru = vcu + (j - nr) * G, RU = ((NT - rt0) - nr * G) * NPN; return ru < RU ? rt0 + nr * G + ru / NPN : -1; }
    __device__ bool next(int i0, Unit& u) const {
        const int i = i0 / dup, nr = nreg(); int j, pn, rt;
        if (i < nr * NPN) { j = i / NPN; pn = i % NPN; rt = rt0 + vcu + j * G; }
        else { const int k = i - nr * NPN, ru = vcu + k * G, RU = ((NT - rt0) - nr * G) * NPN; if (ru >= RU) return false; j = nr + k; rt = rt0 + nr * G + ru / NPN; pn = ru % NPN; }
        const int e = __builtin_amdgcn_readfirstlane((int)tile_e[rt]);
        u.pm = rt; u.pn = pn; u.aux = j; u.e = e; u.A = GATHER ? A : A + (size_t)rt * atile; u.B = W + (size_t)e * wstride + (size_t)pn * btile; return true;
    }
};

__device__ __forceinline__ const char* uptr(const char* p) {
    const unsigned long long v = (unsigned long long)p; const unsigned lo = __builtin_amdgcn_readfirstlane((unsigned)v), hi = __builtin_amdgcn_readfirstlane((unsigned)(v >> 32));
    return (const char*)(((unsigned long long)hi << 32) | lo); }
#define PG8_WAIT_V(n) asm volatile("s_waitcnt vmcnt(" #n ")" ::: "memory")
#define PG8_WAIT_L(n) asm volatile("s_waitcnt lgkmcnt(" #n ")" ::: "memory")
#define PG8_BAR __builtin_amdgcn_s_barrier()
#define PG8_SCHED __builtin_amdgcn_sched_barrier(0)

template <class Epi, class Sched, bool GATHER>
__device__ __forceinline__ void gemm_phase(LAS unsigned char* lds, const int K, const Sched& S, const Epi& E, const LAS int* toks, const int wave0) {
    const int tid = opaque_tid(wave0), wid = __builtin_amdgcn_readfirstlane(tid >> 6), lane = tid & 63, wr = wid >> 2, wc = wid & 3, fr = lane & 15, fq = lane >> 4;
    const int nt = K / BK;
    unsigned voffA[2][2], voffB[2];
#pragma unroll
    for (int i = 0; i < 2; ++i) { int R, C; stage_rc(tid * 16 + i * 8192, R, C); const int Rb = (R & ~31) + perm32(R & 31);
        voffB[i] = (unsigned)(Rb * K + C) * 2u;
        voffA[0][i] = (unsigned)(R * K + C) * 2u; voffA[1][i] = (unsigned)((R + HALF) * K + C) * 2u; }
    const size_t kstep = (size_t)(BK * 2);
    const size_t hstep = (size_t)HALF * K * 2;
    const unsigned ldsw = (unsigned)wid * 1024u;
    const int aoff = lds_byte(wr * 64 + fr, fq * 8), boff = lds_byte(wc * 32 + fr, fq * 8);
#define PG8_SA(b, h) (((b) * 2 + (h)) * HTB)
#define PG8_SB(b, h) ((4 + (b) * 2 + (h)) * HTB)
#define PG8_STAGEA(bufoff, gbase, h) do { _Pragma("unroll") for (int _i = 0; _i < 2; ++_i) { unsigned vo_ = voffA[h][_i]; asm volatile("" : "+v"(vo_)); \
        __builtin_amdgcn_global_load_lds((const unsigned*)((const char*)(gbase) + vo_), (LAS unsigned*)(lds + (bufoff) + ldsw + _i * 8192), 16, 0, 0); } } while (0)
#define PG8_STAGEB(bufoff, gbase) do { _Pragma("unroll") for (int _i = 0; _i < 2; ++_i) { unsigned vo_ = voffB[_i]; asm volatile("" : "+v"(vo_)); \
        __builtin_amdgcn_global_load_lds((const unsigned*)((const char*)(gbase) + vo_), (LAS unsigned*)(lds + (bufoff) + ldsw + _i * 8192), 16, 0, 0); } } while (0)
#define PG8_LDA(dst, b, h) do { _Pragma("unroll") for (int m = 0; m < 4; ++m) _Pragma("unroll") for (int k = 0; k < 2; ++k) dst[m][k] = *(const LAS bf16x8*)(lds + PG8_SA(b, h) + aoff + m * 2048 + k * 1024); } while (0)
#define PG8_LDB(dst, b, h) do { _Pragma("unroll") for (int n = 0; n < 2; ++n) _Pragma("unroll") for (int k = 0; k < 2; ++k) dst[n][k] = *(const LAS bf16x8*)(lds + PG8_SB(b, h) + boff + n * 2048 + k * 1024); } while (0)
#define PG8_MMA(ai, bj, At, Bt) do { __builtin_amdgcn_s_setprio(1); _Pragma("unroll") for (int m = 0; m < 4; ++m) _Pragma("unroll") for (int n = 0; n < 2; ++n) _Pragma("unroll") for (int k = 0; k < 2; ++k) \
        acc[ai][bj][m][n] = __builtin_amdgcn_mfma_f32_16x16x32_bf16(Bt[n][k], At[m][k], acc[ai][bj][m][n], 0, 0, 0); __builtin_amdgcn_s_setprio(0); } while (0)
#define PG8_SETTOK(uu) do { if constexpr (GATHER) { const LAS int* tk_ = toks + (uu).aux * 256; const int t3_ = opaque_tid(wave0); _Pragma("unroll") for (int _i = 0; _i < 2; ++_i) { \
        int R_, C_; stage_rc(t3_ * 16 + _i * 8192, R_, C_); \
        voffA[0][_i] = (unsigned)(tk_[R_] * K + C_) * 2u; voffA[1][_i] = (unsigned)(tk_[R_ + HALF] * K + C_) * 2u; } } } while (0)
    Unit cur, nxt; int ui = 0;
    if (!S.next(0, cur)) return;
    f32x4 acc[2][2][4][2];
#pragma unroll
    for (int a = 0; a < 2; ++a)
#pragma unroll
        for (int b = 0; b < 2; ++b)
#pragma unroll
            for (int m = 0; m < 4; ++m)
#pragma unroll
                for (int n = 0; n < 2; ++n) acc[a][b][m][n] = (f32x4){0.f, 0.f, 0.f, 0.f};
    bf16x8 At[4][2], B0[2][2], B1[2][2];
    const char* cA = uptr(cur.A); const char* cB = uptr(cur.B);
    PG8_SETTOK(cur);
    PG8_STAGEB(PG8_SB(0, 0), cB); PG8_STAGEB(PG8_SB(0, 1), cB + hstep); PG8_STAGEA(PG8_SA(0, 0), cA, 0); PG8_STAGEA(PG8_SA(0, 1), cA, 1);
    if (wr == 1) PG8_BAR;
    PG8_WAIT_V(2); PG8_BAR;
    PG8_STAGEB(PG8_SB(1, 0), cB + kstep); PG8_STAGEA(PG8_SA(1, 0), cA + kstep, 0); PG8_STAGEB(PG8_SB(1, 1), cB + hstep + kstep);
    PG8_WAIT_V(6); PG8_BAR;
    for (;;) {
        const bool has_next = S.next(ui + 1, nxt);
        const char* nA = uptr(has_next ? nxt.A : cA); const char* nB = uptr(has_next ? nxt.B : cB);
        for (int t = 0; t < nt; t += 2) {
            const bool last = (t == nt - 2);
            int tk = t * (BK * 2); asm volatile("" : "+s"(tk));
            const char* a1 = cA + tk + kstep;
            const char* a2 = last ? nA : cA + tk + 2 * kstep; const char* b2 = last ? nB : cB + tk + 2 * kstep;
            const char* a3 = a2 + kstep; const char* b3 = b2 + kstep;
            PG8_LDB(B0, 0, 0); PG8_LDB(B1, 0, 1); PG8_SCHED; PG8_LDA(At, 0, 0); PG8_STAGEA(PG8_SA(1, 1), a1, 1);
            if (GATHER) { if (last && has_next) PG8_SETTOK(nxt); }
            PG8_WAIT_V(8); PG8_WAIT_L(0); PG8_BAR; PG8_MMA(0, 0, At, B0); PG8_MMA(0, 1, At, B1); PG8_BAR; PG8_SCHED;
            PG8_LDA(At, 0, 1); PG8_STAGEB(PG8_SB(0, 0), b2); PG8_STAGEB(PG8_SB(0, 1), b2 + hstep); PG8_STAGEA(PG8_SA(0, 0), a2, 0);
            PG8_WAIT_V(8); PG8_WAIT_L(0); PG8_BAR; PG8_MMA(1, 0, At, B0); PG8_MMA(1, 1, At, B1); PG8_BAR; PG8_SCHED;
            PG8_LDB(B0, 1, 0); PG8_LDB(B1, 1, 1); PG8_SCHED; PG8_LDA(At, 1, 0); PG8_STAGEA(PG8_SA(0, 1), a2, 1);
            PG8_WAIT_V(8); PG8_WAIT_L(0); PG8_BAR; PG8_MMA(0, 0, At, B0); PG8_MMA(0, 1, At, B1); PG8_BAR; PG8_SCHED;
            PG8_LDA(At, 1, 1); PG8_STAGEB(PG8_SB(1, 0), b3); PG8_STAGEB(PG8_SB(1, 1), b3 + hstep); PG8_STAGEA(PG8_SA(1, 0), a3, 0);
            PG8_WAIT_V(8); PG8_WAIT_L(0); PG8_BAR; PG8_MMA(1, 0, At, B0); PG8_MMA(1, 1, At, B1); PG8_BAR; PG8_SCHED;
        }
        if (wr == 0) PG8_BAR;
        { const int l2_ = opaque_tid(wave0) & 63; E(acc, cur, wr, wc, l2_ & 15, l2_ >> 4); }
        if (!has_next) break;
#pragma unroll
        for (int a = 0; a < 2; ++a)
#pragma unroll
            for (int b = 0; b < 2; ++b)
#pragma unroll
                for (int m = 0; m < 4; ++m)
#pragma unroll
                    for (int n = 0; n < 2; ++n) acc[a][b][m][n] = (f32x4){0.f, 0.f, 0.f, 0.f};
        cur = nxt; cA = nA; cB = nB; ++ui;
        if (wr == 1) PG8_BAR;
    }
    PG8_WAIT_V(0);
    PG8_BAR;
#undef PG8_SA
#undef PG8_SB
#undef PG8_STAGEA
#undef PG8_STAGEB
#undef PG8_LDA
#undef PG8_LDB
#undef PG8_MMA
#undef PG8_SETTOK
}

typedef f32x4 Acc[2][2][4][2];
__device__ __forceinline__ v4u pack8(f32x4 v0, f32x4 v1) { v4u w; w.x = cvt_pk_bf16(v0[0], v0[1]); w.y = cvt_pk_bf16(v0[2], v0[3]); w.z = cvt_pk_bf16(v1[0], v1[1]); w.w = cvt_pk_bf16(v1[2], v1[3]); return w; }
__device__ __forceinline__ void unpack8(v4u w, f32x4& v0, f32x4& v1) { v0 = (f32x4){bf_lo(w.x), bf_hi(w.x), bf_lo(w.y), bf_hi(w.y)}; v1 = (f32x4){bf_lo(w.z), bf_hi(w.z), bf_lo(w.w), bf_hi(w.w)}; }

struct EpiInProj {
    bf16 *U, *Q, *Kb, *V, *G; const float* bgate;
    __device__ __forceinline__ void operator()(const Acc& acc, const Unit& u, int wr, int wc, int fr, int fq) const {
        const int row0 = u.pm * BM + wr * 64 + fr; const int colt = u.pn * BM;
        const bool gate = colt >= 2048;
        bf16* base; int ldc, coll;
        if (gate) { base = G; ldc = 2048; coll = colt - 2048; }
        else { const int s = colt >> 9; base = s == 0 ? U : (s == 1 ? Q : (s == 2 ? Kb : V)); ldc = 512; coll = colt & 511; }
        const int col0 = coll + wc * 32 + 8 * fq;
        const float osc = (!gate && (colt >> 9) == 1) ? QSCALE : 1.0f;
        f32x4 bv[2][2];
#pragma unroll
        for (int bj = 0; bj < 2; ++bj)
#pragma unroll
            for (int n = 0; n < 2; ++n) bv[bj][n] = gate ? *(const f32x4*)(bgate + col0 + bj * HALF + 4 * n) : (f32x4){0.f, 0.f, 0.f, 0.f};
#pragma unroll
        for (int ai = 0; ai < 2; ++ai)
#pragma unroll
            for (int m = 0; m < 4; ++m) { bf16* rowp = base + (size_t)(row0 + ai * HALF + m * 16) * ldc + col0;
#pragma unroll
                for (int bj = 0; bj < 2; ++bj) { f32x4 v0 = acc[ai][bj][m][0] + bv[bj][0], v1 = acc[ai][bj][m][1] + bv[bj][1];
                    if (gate) {
#pragma unroll
                        for (int q = 0; q < 4; ++q) { v0[q] = sigmoidf_(v0[q]); v1[q] = sigmoidf_(v1[q]); } }
                    *(v4u*)(rowp + bj * HALF) = pack8(v0 * osc, v1 * osc); } }
    }
};
template <bool ADD> struct EpiGate {
    const bf16* G; int goff; const bf16* Tin; bf16* O;
    __device__ __forceinline__ void operator()(const Acc& acc, const Unit& u, int wr, int wc, int fr, int fq) const {
        const int row0 = u.pm * BM + wr * 64 + fr; const int col0 = u.pn * BM + wc * 32 + 8 * fq;
#pragma unroll
        for (int ai = 0; ai < 2; ++ai)
#pragma unroll
            for (int m = 0; m < 4; ++m) { const size_t row = (size_t)(row0 + ai * HALF + m * 16);
#pragma unroll
                for (int bj = 0; bj < 2; ++bj) { const int col = col0 + bj * HALF;
                    const v4u gw = *(const v4u*)(G + row * 2048 + goff + col); f32x4 g0, g1; unpack8(gw, g0, g1);
                    f32x4 v0 = acc[ai][bj][m][0] * g0, v1 = acc[ai][bj][m][1] * g1;
                    if (ADD) { const v4u tw = *(const v4u*)(Tin + row * DM + col); f32x4 t0, t1; unpack8(tw, t0, t1); v0 += t0; v1 += t1; }
                    *(v4u*)(O + row * DM + col) = pack8(v0, v1); } }
    }
};
struct EpiResid {
    const float* X; float* Z;
    __device__ __forceinline__ void operator()(const Acc& acc, const Unit& u, int wr, int wc, int fr, int fq) const {
        const int row0 = u.pm * BM + wr * 64 + fr; const int col0 = u.pn * BM + wc * 32 + 8 * fq;
#pragma unroll
        for (int ai = 0; ai < 2; ++ai)
#pragma unroll
            for (int m = 0; m < 4; ++m) { const size_t off = (size_t)(row0 + ai * HALF + m * 16) * DM + col0;
#pragma unroll
                for (int bj = 0; bj < 2; ++bj)
#pragma unroll
                    for (int n = 0; n < 2; ++n) { const f32x4 xv = *(const f32x4*)(X + off + bj * HALF + 4 * n); *(f32x4*)(Z + off + bj * HALF + 4 * n) = xv * ALPHA + acc[ai][bj][m][n]; } }
    }
};
struct EpiLogits {
    float* L;
    __device__ __forceinline__ void operator()(const Acc& acc, const Unit& u, int wr, int wc, int fr, int fq) const {
        const int row0 = u.pm * BM + wr * 64 + fr; const int col0 = wc * 32 + 8 * fq;
#pragma unroll
        for (int ai = 0; ai < 2; ++ai)
#pragma unroll
            for (int m = 0; m < 4; ++m) { const size_t off = (size_t)(row0 + ai * HALF + m * 16) * NE + col0;
#pragma unroll
                for (int bj = 0; bj < 2; ++bj)
#pragma unroll
                    for (int n = 0; n < 2; ++n) *(f32x4*)(L + off + bj * HALF + 4 * n) = acc[ai][bj][m][n]; }
    }
};
struct EpiSwiglu {
    bf16* HID;
    __device__ __forceinline__ void operator()(const Acc& acc, const Unit& u, int wr, int wc, int fr, int fq) const {
        const int row0 = u.pm * BM + wr * 64 + fr; const int col0 = u.pn * HALF + wc * 32 + 8 * fq;
#pragma unroll
        for (int ai = 0; ai < 2; ++ai)
#pragma unroll
            for (int m = 0; m < 4; ++m) { f32x4 h[2];
#pragma unroll
                for (int n = 0; n < 2; ++n) { const f32x4 g = acc[ai][0][m][n], up = acc[ai][1][m][n];
#pragma unroll
                    for (int q = 0; q < 4; ++q) h[n][q] = g[q] * sigmoidf_(g[q]) * up[q]; }
                *(v4u*)((char*)HID + (unsigned)((row0 + ai * HALF + m * 16) * ED + col0) * 2u) = pack8(h[0], h[1]); }
    }
};
struct EpiDownRouted {
    bf16* OS; const LAS int* lslot; const LAS float* lw;
    __device__ __forceinline__ void operator()(const Acc& acc, const Unit& u, int wr, int wc, int fr, int fq) const {
        const int col0 = u.pn * BM + wc * 64 + 16 * fq;
#pragma unroll
        for (int ai = 0; ai < 2; ++ai)
#pragma unroll
            for (int m = 0; m < 4; ++m) { const int lr = u.aux * 256 + wr * 64 + fr + ai * HALF + m * 16; const int slot = lslot[lr]; const float w = lw[lr];
                if (slot >= 0) { const unsigned ob = (unsigned)(slot * DM + col0) * 2u;
#pragma unroll
                    for (int bj = 0; bj < 2; ++bj) *(v4u*)((char*)OS + ob + bj * 16) = pack8(acc[ai][bj][m][0] * w, acc[ai][bj][m][1] * w); } }
    }
};
struct EpiDownShared {
    bf16* YS; int shared_row0;
    __device__ __forceinline__ void operator()(const Acc& acc, const Unit& u, int wr, int wc, int fr, int fq) const {
        const int row0 = u.pm * BM + wr * 64 + fr - shared_row0; const int col0 = u.pn * BM + wc * 64 + 16 * fq;
#pragma unroll
        for (int ai = 0; ai < 2; ++ai)
#pragma unroll
            for (int m = 0; m < 4; ++m) { const unsigned ob = (unsigned)((row0 + ai * HALF + m * 16) * DM + col0) * 2u;
#pragma unroll
                for (int bj = 0; bj < 2; ++bj) *(v4u*)((char*)YS + ob + bj * 16) = pack8(acc[ai][bj][m][0], acc[ai][bj][m][1]); }
    }
};
}

namespace att {
constexpr int NW = 8, QBLK = 32, KVBLK = 64, PITCH = 512, QROWS = 128;
constexpr float THR2 = 8.f * 1.4426950408889634f;
constexpr int SHM_V = KVBLK * 128 * 2, SHM_K = KVBLK * 128 * 2;
constexpr int NSLOT = 4, L_K = 0, L_V = NSLOT * SHM_K, L_WS = LT_ATT, L_TAB = L_WS + NW * 64 * 4, L_LAM = L_TAB + NH * 452 * 4, L_END = L_LAM + 64;
constexpr int L_XCH = 0, L_STG = 65536;
static_assert(L_STG + 32768 <= 131072 && L_V + NSLOT * SHM_V <= 131072 && L_END <= LDS_BYTES, "attention LDS map");
#define SBAR() __builtin_amdgcn_sched_barrier(0)
#define KSWZ(row, colB) ((row) * 256 + ((colB) ^ (((row) & 7) << 4)))
__device__ __forceinline__ int crow(int r, int hi) { return (r & 3) + 8 * (r >> 2) + 4 * hi; }
__device__ __forceinline__ int v_st(int k, int c) { const int kk = (k & ~0xC) | ((k & 4) << 1) | ((k & 8) >> 1); return ((kk >> 3) * 4 + (c >> 5)) * 512 + ((kk & 7) * 32 + (c & 31)) * 2; }
__device__ __forceinline__ int v_rd_base(int lane) { return ((lane & 3) << 3) | (((lane >> 2) & 3) << 6) | (((lane >> 4) & 1) << 5) | (((lane >> 5) & 1) << 8); }
constexpr int v_rd_off(int d0, int ks, int half) { return d0 * 512 + ks * 4096 + half * 2048; }

__device__ __forceinline__ void partialSM(f32x16& p0, f32x16& p1, float& m_reg, float& alpha, const bool first) {
    float pmax = p0[0];
#pragma unroll
    for (int r = 1; r < 16; ++r) pmax = fmaxf(pmax, p0[r]);
#pragma unroll
    for (int r = 0; r < 16; ++r) pmax = fmaxf(pmax, p1[r]);
    { auto rr = __builtin_amdgcn_permlane32_swap(__float_as_uint(pmax), __float_as_uint(pmax), false, false);
      pmax = fmaxf(__uint_as_float(rr[0]), __uint_as_float(rr[1])); }
    if (__builtin_expect(!first && __all(pmax <= THR2), 1)) { alpha = 1.f; }
    else { const float mn = first ? pmax : fmaxf(pmax, 0.f); alpha = first ? 1.f : __builtin_amdgcn_exp2f(-mn); m_reg += mn;
#pragma unroll
        for (int r = 0; r < 16; ++r) { p0[r] -= mn; p1[r] -= mn; } }
#pragma unroll
    for (int r = 0; r < 16; ++r) p0[r] = __builtin_amdgcn_exp2f(p0[r]);
}
__device__ __forceinline__ void finishSM(f32x16& p0, f32x16& p1, float alpha, float& l_reg, bf16x8& pa0, bf16x8& pa1, bf16x8& pa2, bf16x8& pa3) {
#pragma unroll
    for (int r = 0; r < 16; ++r) p1[r] = __builtin_amdgcn_exp2f(p1[r]);
    float ps = 0;
#pragma unroll
    for (int r = 0; r < 16; ++r) ps += p0[r];
#pragma unroll
    for (int r = 0; r < 16; ++r) ps += p1[r];
    { auto rr = __builtin_amdgcn_permlane32_swap(__float_as_uint(ps), __float_as_uint(ps), false, false);
      ps = __uint_as_float(rr[0]) + __uint_as_float(rr[1]); }
    l_reg = l_reg * alpha + ps;
#define PK4(P, BASE, OUT) do { unsigned a0 = cvt_pk_bf16(P[BASE + 0], P[BASE + 1]), a1 = cvt_pk_bf16(P[BASE + 2], P[BASE + 3]);   \
    unsigned b0 = cvt_pk_bf16(P[BASE + 4], P[BASE + 5]), b1 = cvt_pk_bf16(P[BASE + 6], P[BASE + 7]);                              \
    auto r0 = __builtin_amdgcn_permlane32_swap(a0, b0, false, false); auto r1 = __builtin_amdgcn_permlane32_swap(a1, b1, false, false); \
    v4u w = {r0[0], r1[0], r0[1], r1[1]}; OUT = *reinterpret_cast<bf16x8*>(&w); } while (0)
    PK4(p0, 0, pa0); PK4(p0, 8, pa1); PK4(p1, 0, pa2); PK4(p1, 8, pa3);
#undef PK4
}
__device__ __forceinline__ float fadd_s(float a, float b) { float r; asm("v_add_f32_e32 %0, %1, %2" : "=v"(r) : "v"(a), "v"(b)); return r; }
__device__ __forceinline__ void qkt(f32x16& p0, f32x16& p1, const LAS char* Ks, const bf16x8* qr, int r32, int hi, int kcb, float init) {
#pragma unroll
    for (int r = 0; r < 16; ++r) { p0[r] = init; p1[r] = init; }
#pragma unroll
    for (int d0 = 0; d0 < 4; ++d0) { const int cb = kcb + (d0 * 16 + hi * 8) * 2;
        const bf16x8 b0 = *(const LAS bf16x8*)(Ks + KSWZ(r32, cb));
        const bf16x8 b1 = *(const LAS bf16x8*)(Ks + KSWZ(32 + r32, cb));
        p0 = __builtin_amdgcn_mfma_f32_32x32x16_bf16(b0, qr[d0], p0, 0, 0, 0);
        p1 = __builtin_amdgcn_mfma_f32_32x32x16_bf16(b1, qr[d0], p1, 0, 0, 0); }
}
typedef short v4i16_t __attribute__((ext_vector_type(4)));
__device__ __forceinline__ s16x4 vtr(const LAS char* p) { return __builtin_bit_cast(s16x4, __builtin_amdgcn_ds_read_tr16_b64_v4i16((LAS v4i16_t*)p)); }
__device__ __forceinline__ void pv_d0(f32x16* o, const LAS char* vp, bf16x8 pa0, bf16x8 pa1, bf16x8 pa2, bf16x8 pa3) {
    s16x4 lo[4][4], hi[4][4];
#define PVRD(ks) do { _Pragma("unroll") for (int d0 = 0; d0 < 4; ++d0) { lo[ks][d0] = vtr(vp + v_rd_off(d0, ks, 0)); hi[ks][d0] = vtr(vp + v_rd_off(d0, ks, 1)); } } while (0)
#define PVMM(ks, PA) do { _Pragma("unroll") for (int d0 = 0; d0 < 4; ++d0) o[d0] = __builtin_amdgcn_mfma_f32_32x32x16_bf16(PA, \
        ((bf16x8){lo[ks][d0][0], lo[ks][d0][1], lo[ks][d0][2], lo[ks][d0][3], hi[ks][d0][0], hi[ks][d0][1], hi[ks][d0][2], hi[ks][d0][3]}), o[d0], 0, 0, 0); } while (0)
    PVRD(0); PVRD(1); SBAR();
    PVMM(0, pa0); PVRD(2); SBAR();
    PVMM(1, pa1); PVRD(3); SBAR();
    PVMM(2, pa2); PVMM(3, pa3);
#undef PVRD
#undef PVMM
}

__device__ __forceinline__ void attn_pass(const bf16* __restrict__ Qw, const bf16* __restrict__ Kh, const bf16* __restrict__ Vh, int q0, LAS char* lds, const LAS float* tab,
                                          f32x16 (&o)[4], float& l_out, const int wave0) {
    const int tid = opaque_tid(wave0), wid = __builtin_amdgcn_readfirstlane(tid >> 6), lane = tid & 63, r32 = lane & 31, hi = lane >> 5;
    LAS float* ws = (LAS float*)(lds + L_WS) + wid * 64; LAS float* al_l = ws + 32;
    float m_reg = 0.f, l_reg = 0.f; bf16x8 qr[4];
#pragma unroll
    for (int d = 0; d < 4; ++d) o[d] = (f32x16){0.f, 0.f, 0.f, 0.f, 0.f, 0.f, 0.f, 0.f, 0.f, 0.f, 0.f, 0.f, 0.f, 0.f, 0.f, 0.f};
#pragma unroll
    for (int d0 = 0; d0 < 4; ++d0) qr[d0] = *reinterpret_cast<const bf16x8*>(Qw + d0 * 16);
    unsigned kgo[2], vgo[2];
#pragma unroll
    for (int i = 0; i < 2; ++i) { const int a = (wid * 2 + i) * 1024 + 16 * lane;
        { const int row = a >> 8, cb = (a & 255) ^ ((row & 7) << 4); kgo[i] = (unsigned)(row * PITCH * 2 + cb); }
        { const int sub = a >> 9, w = (a & 511) >> 1, kk = (sub >> 2) * 8 + (w >> 5), k = (kk & ~0xC) | ((kk & 4) << 1) | ((kk & 8) >> 1), c = (sub & 3) * 32 + (w & 31); vgo[i] = (unsigned)(k * PITCH * 2 + c * 2); } }
    const unsigned pw = (unsigned)wid * 2048u;
#define DMA(t, s) do { const char* kt_ = (const char*)(Kh + (size_t)(t) * KVBLK * PITCH); const char* vt_ = (const char*)(Vh + (size_t)(t) * KVBLK * PITCH); \
    _Pragma("unroll") for (int _i = 0; _i < 2; ++_i) { unsigned ko_ = kgo[_i], vo_ = vgo[_i]; asm volatile("" : "+v"(ko_), "+v"(vo_)); \
        __builtin_amdgcn_global_load_lds((const unsigned*)(kt_ + ko_), (LAS unsigned*)(lds + L_K + (s) * SHM_K + pw + _i * 1024), 16, 0, 0); \
        __builtin_amdgcn_global_load_lds((const unsigned*)(vt_ + vo_), (LAS unsigned*)(lds + L_V + (s) * SHM_V + pw + _i * 1024), 16, 0, 0); } } while (0)
    const LAS char* vb0 = lds + L_V + v_rd_base(lane);
    const int kcb = (wid >> 2) * 128;
    const int qwlo = q0 + (wid & 3) * QBLK;
    const int qpos = qwlo + r32;
#define RESC(a) do { if (__any((a) < 1.f)) { if (hi == 0) al_l[r32] = (a); asm volatile("s_waitcnt lgkmcnt(0)" ::: "memory"); \
    _Pragma("unroll") for (int d = 0; d < 4; ++d) _Pragma("unroll") for (int r = 0; r < 16; ++r) o[d][r] *= al_l[crow(r, hi)]; } } while (0)
#define BFAR(k0) (((k0) + 63 - qwlo <= -128) || ((k0) - (qwlo + 31) >= 128))
#define BINIT(k0) ((((k0) + 63 - qwlo <= -128) ? tab[224 - 128] : (((k0) - (qwlo + 31) >= 128) ? tab[224 + 128] : 0.f)) - m_reg)
#define BNEAR(P0, P1, k0) do { if (!BFAR(k0)) { const LAS float* tb_ = tab + ((k0) - qpos + 224 + 4 * hi); \
    _Pragma("unroll") for (int r4 = 0; r4 < 4; ++r4) { \
        _Pragma("unroll") for (int rr = 0; rr < 4; ++rr) { P0[r4 * 4 + rr] += tb_[8 * r4 + rr]; P1[r4 * 4 + rr] += tb_[8 * r4 + rr + 32]; } \
        asm volatile("" ::: "memory"); } } } while (0)
#define WAITBAR(n) asm volatile("s_waitcnt vmcnt(" #n ") lgkmcnt(0)\n\ts_barrier" ::: "memory")
#define KFR(d0, half) (*(const LAS bf16x8*)(ks_ + KSWZ((half) * 32 + r32, kcb + ((d0) * 16 + hi * 8) * 2)))
#define PK4(P, BASE, OUT) do { unsigned a0 = cvt_pk_bf16(P[BASE + 0], P[BASE + 1]), a1 = cvt_pk_bf16(P[BASE + 2], P[BASE + 3]);   \
    unsigned b0 = cvt_pk_bf16(P[BASE + 4], P[BASE + 5]), b1 = cvt_pk_bf16(P[BASE + 6], P[BASE + 7]);                              \
    auto r0 = __builtin_amdgcn_permlane32_swap(a0, b0, false, false); auto r1 = __builtin_amdgcn_permlane32_swap(a1, b1, false, false); \
    v4u w = {r0[0], r1[0], r0[1], r1[1]}; OUT = *reinterpret_cast<bf16x8*>(&w); } while (0)
#define QKFS(P0, P1, Q0, Q1, alQ, Ks, INIT) do { const LAS char* ks_ = (Ks); const float in_ = (INIT); float ps_ = 0.f; \
    const bf16x8 ka0 = KFR(0, 0), kb0 = KFR(0, 1), ka1 = KFR(1, 0), kb1 = KFR(1, 1); \
    _Pragma("unroll") for (int r = 0; r < 16; ++r) { P0[r] = in_; P1[r] = in_; } \
    SBAR(); \
    P0 = __builtin_amdgcn_mfma_f32_32x32x16_bf16(ka0, qr[0], P0, 0, 0, 0); P1 = __builtin_amdgcn_mfma_f32_32x32x16_bf16(kb0, qr[0], P1, 0, 0, 0); \
    const bf16x8 ka2 = KFR(2, 0), kb2 = KFR(2, 1); \
    _Pragma("unroll") for (int r = 0; r < 8; ++r) { Q1[r] = __builtin_amdgcn_exp2f(Q1[r]); ps_ = fadd_s(ps_, Q0[r]); } \
    SBAR(); \
    P0 = __builtin_amdgcn_mfma_f32_32x32x16_bf16(ka1, qr[1], P0, 0, 0, 0); P1 = __builtin_amdgcn_mfma_f32_32x32x16_bf16(kb1, qr[1], P1, 0, 0, 0); \
    const bf16x8 ka3 = KFR(3, 0), kb3 = KFR(3, 1); \
    _Pragma("unroll") for (int r = 8; r < 16; ++r) { Q1[r] = __builtin_amdgcn_exp2f(Q1[r]); ps_ = fadd_s(ps_, Q0[r]); } \
    SBAR(); \
    P0 = __builtin_amdgcn_mfma_f32_32x32x16_bf16(ka2, qr[2], P0, 0, 0, 0); P1 = __builtin_amdgcn_mfma_f32_32x32x16_bf16(kb2, qr[2], P1, 0, 0, 0); \
    float ps2_ = Q1[0]; _Pragma("unroll") for (int r = 1; r < 16; ++r) ps2_ = fadd_s(ps2_, Q1[r]); ps_ = fadd_s(ps_, ps2_); \
    { auto rr = __builtin_amdgcn_permlane32_swap(__float_as_uint(ps_), __float_as_uint(ps_), false, false); ps_ = __uint_as_float(rr[0]) + __uint_as_float(rr[1]); } \
    l_reg = l_reg * (alQ) + ps_; PK4(Q0, 0, pa0); \
    SBAR(); \
    P0 = __builtin_amdgcn_mfma_f32_32x32x16_bf16(ka3, qr[3], P0, 0, 0, 0); P1 = __builtin_amdgcn_mfma_f32_32x32x16_bf16(kb3, qr[3], P1, 0, 0, 0); \
    PK4(Q0, 8, pa1); PK4(Q1, 0, pa2); PK4(Q1, 8, pa3); \
    SBAR(); } while (0)
#define SLOTK(t) (lds + L_K + ((t) & 3) * SHM_K)
#define SLOTV(t) (vb0 + ((t) & 3) * SHM_V)
#define STEP_A(P0, P1, alP, Q0, Q1, alQ, t, more) do { \
    SBAR(); if (more) DMA((t) + 1, ((t) + 1) & 3); SBAR(); \
    QKFS(P0, P1, Q0, Q1, alQ, SLOTK(t), BINIT((t) * KVBLK)); BNEAR(P0, P1, (t) * KVBLK); SBAR(); \
    pv_d0(o, SLOTV((t) - 1), pa0, pa1, pa2, pa3); partialSM(P0, P1, m_reg, alP, false); \
    WAITBAR(0); RESC(alP); } while (0)
#define STEP_B(P0, P1, Q0, Q1, alQ, t, more) do { \
    SBAR(); if (more) DMA((t) + 1, ((t) + 1) & 3); SBAR(); \
    pv_d0(o, SLOTV((t) - 2), pa0, pa1, pa2, pa3); partialSM(Q0, Q1, m_reg, alQ, false); RESC(alQ); SBAR(); \
    QKFS(P0, P1, Q0, Q1, alQ, SLOTK(t), BINIT((t) * KVBLK)); BNEAR(P0, P1, (t) * KVBLK); \
    WAITBAR(0); } while (0)
    f32x16 pA0, pA1, pB0, pB1; float alA = 1.f, alB = 1.f; bf16x8 pa0, pa1, pa2, pa3; constexpr int NT = SEQ / KVBLK;
    DMA(0, 0); DMA(1, 1);
    WAITBAR(4);
    if (wid < 4) {
        qkt(pA0, pA1, SLOTK(0), qr, r32, hi, kcb, BINIT(0)); BNEAR(pA0, pA1, 0); partialSM(pA0, pA1, m_reg, alA, true);
        WAITBAR(0);
        STEP_A(pB0, pB1, alB, pA0, pA1, alA, 1, true);
        for (int t = 2; t + 1 < NT; t += 2) {
            STEP_A(pA0, pA1, alA, pB0, pB1, alB, t, true);
            STEP_A(pB0, pB1, alB, pA0, pA1, alA, t + 1, (t + 2 < NT));
        }
        finishSM(pB0, pB1, alB, l_reg, pa0, pa1, pa2, pa3); SBAR();
        pv_d0(o, SLOTV(NT - 1), pa0, pa1, pa2, pa3);
    } else {
        qkt(pA0, pA1, SLOTK(0), qr, r32, hi, kcb, BINIT(0)); BNEAR(pA0, pA1, 0);
        WAITBAR(0);
        SBAR(); DMA(2, 2); SBAR();
        partialSM(pA0, pA1, m_reg, alA, true); SBAR();
        QKFS(pB0, pB1, pA0, pA1, alA, SLOTK(1), BINIT(KVBLK)); BNEAR(pB0, pB1, KVBLK);
        WAITBAR(0);
        for (int t = 2; t + 1 < NT; t += 2) {
            STEP_B(pA0, pA1, pB0, pB1, alB, t, true);
            STEP_B(pB0, pB1, pA0, pA1, alA, t + 1, (t + 2 < NT));
        }
        pv_d0(o, SLOTV(NT - 2), pa0, pa1, pa2, pa3); partialSM(pB0, pB1, m_reg, alB, false); RESC(alB);
        finishSM(pB0, pB1, alB, l_reg, pa0, pa1, pa2, pa3); SBAR();
        pv_d0(o, SLOTV(NT - 1), pa0, pa1, pa2, pa3);
    }
    l_out = l_reg;
    __syncthreads();
#undef SLOTK
#undef SLOTV
#undef STEP_A
#undef STEP_B
#undef DMA
#undef RESC
#undef BINIT
#undef BFAR
#undef BNEAR
#undef WAITBAR
#undef QKFS
#undef KFR
#undef PK4
}
}

#define XB_TMO      128
#define XB_XCNT(j)  (256  + 64 * (j))
#define XB_XSUB(j)  (1280 + 64 * (j))
#define XB_XGEN(j)  (2304 + 64 * (j))
#define XB_TOP      3328
#define XB_TOPGEN   3392
#define XCD_BAR_WORDS 3456
#define XB_SPIN_CAP (1u << 18)
__device__ __forceinline__ unsigned xb_ld(unsigned* p)              { return __hip_atomic_load(p, __ATOMIC_RELAXED, __HIP_MEMORY_SCOPE_AGENT); }
__device__ __forceinline__ unsigned xb_add(unsigned* p, unsigned v) { return __hip_atomic_fetch_add(p, v, __ATOMIC_RELAXED, __HIP_MEMORY_SCOPE_AGENT); }
__device__ __forceinline__ unsigned xb_xcc_id() { return (unsigned)__builtin_amdgcn_s_getreg((3 << 11) | 20) & 0xFu; }
#define XB_SPIN(cond, bar) do { unsigned _sp = 0; while (cond) { __builtin_amdgcn_s_sleep(1); \
    if ((++_sp & 255u) == 0u) { if (xb_ld(&(bar)[XB_TMO])) break; if (_sp > XB_SPIN_CAP) { atomicAdd(&(bar)[XB_TMO], 1u); break; } } } } while (0)
struct XcdBarrier { unsigned* bar; unsigned x; volatile LAS unsigned* st; };
__device__ __forceinline__ XcdBarrier xcd_barrier_post(unsigned* bar, volatile LAS unsigned* st) {
    XcdBarrier b; b.bar = bar; b.x = xb_xcc_id(); b.st = st;
    if (threadIdx.x == 0) (void)xb_add(&bar[XB_XCNT(b.x)], 1u);
    return b;
}
__device__ __forceinline__ void xcd_barrier_complete(unsigned* bar, unsigned x, unsigned& nloc, unsigned& nx) {
    const unsigned G = gridDim.x * gridDim.y * gridDim.z;
    unsigned sum, cnt, mine, sp = 0u;
    for (;;) {
        sum = 0u; cnt = 0u; mine = 0u;
#pragma unroll
        for (unsigned j = 0; j < 16; ++j) { const unsigned c = xb_ld(&bar[XB_XCNT(j)]); sum += c; cnt += (c > 0u) ? 1u : 0u; mine = (j == x) ? c : mine; }
        if (sum == G) break;
        __builtin_amdgcn_s_sleep(1);
        if ((++sp & 255u) == 0u) { if (xb_ld(&bar[XB_TMO])) break; if (sp > XB_SPIN_CAP) { atomicAdd(&bar[XB_TMO], 1u); break; } }
    }
    nloc = mine > 0u ? mine : 1u; nx = cnt > 0u ? cnt : 1u;
}
__device__ __forceinline__ void xcd_barrier(const XcdBarrier& b) {
    asm volatile("s_waitcnt vmcnt(0)" ::: "memory");
    __syncthreads();
    if (threadIdx.x == 0) {
        unsigned* bar = b.bar;
        __builtin_amdgcn_s_waitcnt(0);
        unsigned nloc = b.st[0], nx = b.st[1];
        if (nloc == 0u) { xcd_barrier_complete(bar, b.x, nloc, nx); b.st[0] = nloc; b.st[1] = nx; }
        const unsigned old = xb_add(&bar[XB_XSUB(b.x)], 1u);
        const unsigned gen = old / nloc;
        if (old + 1u == (gen + 1u) * nloc) {
            __builtin_amdgcn_fence(__ATOMIC_RELEASE, "agent");
            asm volatile("s_waitcnt vmcnt(0)" ::: "memory");
            const unsigned og = xb_add(&bar[XB_TOP], 1u);
            const unsigned tg = og / nx;
            if (og + 1u == (tg + 1u) * nx) xb_add(&bar[XB_TOPGEN], 1u);
            else XB_SPIN(xb_ld(&bar[XB_TOPGEN]) == tg, bar);
            __builtin_amdgcn_fence(__ATOMIC_ACQUIRE, "agent");
            xb_add(&bar[XB_XGEN(b.x)], 1u);
            asm volatile("s_waitcnt vmcnt(0)" ::: "memory");
        } else {
            XB_SPIN(xb_ld(&bar[XB_XGEN(b.x)]) == gen, bar);
            __builtin_amdgcn_fence(__ATOMIC_ACQUIRE, "agent");
            asm volatile("s_waitcnt vmcnt(0)" ::: "memory");
        }
    }
    __syncthreads();
}

struct Args { const float* in[26]; float* out; unsigned char* ws; int ph_lo, ph_hi; };
enum { I_X = 0, I_RELB, I_WIN, I_BGATE, I_WPG, I_PSC, I_WBP, I_LQ1, I_LK1, I_LQ2, I_LK2, I_SUBG, I_WBA, I_WOUT, I_LN1G, I_LN1B, I_WR, I_RB, I_WEG, I_WEU, I_WED, I_WSG, I_WSU, I_WSD, I_LN2G, I_LN2B };

struct TrItem { const float* src; bf16* dst; int ldw, ldt, q0; };
__device__ __forceinline__ void tr_load(const TrItem& t, f32x4 (&v)[8], int lane) {
    const int lr = lane >> 3, lc = (lane & 7) * 4;
#pragma unroll
    for (int j = 0; j < 8; ++j) v[j] = *(const f32x4*)(t.src + (size_t)(lr + 8 * j) * t.ldw + lc);
}
__device__ __forceinline__ void tr_finish(const TrItem& t, const f32x4 (&v)[8], LAS float* scr, int lane) {
    const int lr = lane >> 3, lc = (lane & 7) * 4;
#pragma unroll
    for (int j = 0; j < 8; ++j) { LAS float* d = scr + (lr + 8 * j) * 33 + lc; d[0] = v[j].x; d[1] = v[j].y; d[2] = v[j].z; d[3] = v[j].w; }
    LDS_WAIT(); asm volatile("" ::: "memory");
    const int c = lane & 7;
#pragma unroll
    for (int j = 0; j < 4; ++j) { const int n = (lane >> 3) + 8 * j; const LAS float* s = scr + (8 * c) * 33 + n;
        v4u o; o.x = cvt_pk_bf16(s[0 * 33], s[1 * 33]); o.y = cvt_pk_bf16(s[2 * 33], s[3 * 33]); o.z = cvt_pk_bf16(s[4 * 33], s[5 * 33]); o.w = cvt_pk_bf16(s[6 * 33], s[7 * 33]);
        const int r_ = t.q0 + n; const int drow = t.q0 < 0 ? n : 128 * ((r_ >> 3) & 1) + 8 * (r_ >> 4) + (r_ & 7);
        *(v4u*)(t.dst + (size_t)drow * t.ldt + 8 * c) = o; }
    LDS_WAIT(); asm volatile("" ::: "memory");
}

__device__ __forceinline__ float readlane_f(float v, int l) { return __uint_as_float((unsigned)__builtin_amdgcn_readlane((int)__float_as_uint(v), l)); }
template <int CTRL> __device__ __forceinline__ float dpp_f(float v) { return __uint_as_float((unsigned)__builtin_amdgcn_update_dpp((int)__float_as_uint(v), (int)__float_as_uint(v), CTRL, 0xf, 0xf, false)); }
__device__ __forceinline__ float row_max16(float v) {
    v = fmaxf(v, dpp_f<0xB1>(v)); v = fmaxf(v, dpp_f<0x4E>(v)); v = fmaxf(v, dpp_f<0x141>(v)); v = fmaxf(v, dpp_f<0x140>(v)); return v;
}
__device__ __forceinline__ float wave_max_f(float v) {
    v = row_max16(v);
    const float r0 = readlane_f(v, 0), r1 = readlane_f(v, 16), r2 = readlane_f(v, 32), r3 = readlane_f(v, 48);
    return fmaxf(fmaxf(r0, r1), fmaxf(r2, r3));
}
template <int W> __device__ __forceinline__ void pool_item(const bf16* base, int sp, bf16* dst) {
    v4u v[W]; float a[8];
#pragma unroll
    for (int i = 0; i < W; ++i) { int p = sp - W / 2 + i; p = p < 0 ? 0 : (p > SEQ - 1 ? SEQ - 1 : p); v[i] = *(const v4u*)(base + (size_t)p * PW); }
#pragma unroll
    for (int q = 0; q < 8; ++q) a[q] = 0.f;
#pragma unroll
    for (int i = 0; i < W; ++i) { const int p = sp - W / 2 + i; const float m = (p >= 0 && p < SEQ) ? 1.f : 0.f;
        a[0] += m * bf_lo(v[i].x); a[1] += m * bf_hi(v[i].x); a[2] += m * bf_lo(v[i].y); a[3] += m * bf_hi(v[i].y); a[4] += m * bf_lo(v[i].z); a[5] += m * bf_hi(v[i].z); a[6] += m * bf_lo(v[i].w); a[7] += m * bf_hi(v[i].w); }
    int lo_ = sp - W / 2, hi_ = sp + W / 2; lo_ = lo_ < 0 ? 0 : lo_; hi_ = hi_ > SEQ ? SEQ : hi_;
    const float inv = 1.0f / (float)(hi_ - lo_); const v4u sv = v[W / 2];
    const f32x4 r0 = {a[0] * inv - bf_lo(sv.x), a[1] * inv - bf_hi(sv.x), a[2] * inv - bf_lo(sv.y), a[3] * inv - bf_hi(sv.y)};
    const f32x4 r1 = {a[4] * inv - bf_lo(sv.z), a[5] * inv - bf_hi(sv.z), a[6] * inv - bf_lo(sv.w), a[7] * inv - bf_hi(sv.w)};
    *(v4u*)dst = pg8::pack8(r0, r1);
}

__device__ __forceinline__ void build_tables(LAS unsigned char* lds, const int* CNT, int G, int bx, int tid) {
    LAS int* tot = (LAS int*)(lds + RING_OFF); LAS int* before = tot + 256; LAS int* tstart = tot + 512;
    LAS unsigned short* tile_e = (LAS unsigned short*)(lds + LT_TILE_E); LAS int* ntr_p = (LAS int*)(lds + LT_NTR);
    if (tid < NE) { int bsum = 0, tsum = 0;
#pragma unroll 16
        for (int w = 0; w < G; ++w) { const int v = CNT[w * NE + tid]; tsum += v; bsum += (w < bx) ? v : 0; }
        tot[tid] = tsum; before[tid] = bsum; tstart[tid] = (tsum + 255) >> 8; }
    __syncthreads();
    { LAS int* scan2 = tot + 1280; LAS int* src = tstart; LAS int* dst = scan2;
      for (int off = 1; off < NE; off <<= 1) { if (tid < NE) dst[tid] = src[tid] + (tid >= off ? src[tid - off] : 0); __syncthreads(); LAS int* tmp = src; src = dst; dst = tmp; }
      int incl = 0, mine = 0; if (tid < NE) { incl = src[tid]; mine = (tot[tid] + 255) >> 8; }
      __syncthreads();
      if (tid < NE) { tstart[tid] = incl - mine; if (tid == NE - 1) ntr_p[0] = incl; } }
    __syncthreads();
    const int NTr = ntr_p[0];
    if (tid < NE) { const int ts = tstart[tid], nt_ = (tot[tid] + 255) >> 8; for (int i = 0; i < nt_; ++i) tile_e[ts + i] = (unsigned short)tid; }
    for (int i = tid; i < M / 256; i += NWAVES * 64) tile_e[NTr + i] = (unsigned short)NE;
    __syncthreads();
}

__global__ void __launch_bounds__(NWAVES * 64, 2) fwd_kernel(Args args) {
    extern __shared__ __attribute__((aligned(16))) unsigned char lds_raw[];
    LAS unsigned char* lds = (LAS unsigned char*)lds_raw;
    volatile LAS unsigned* MISC = (volatile LAS unsigned*)(lds + MISC_OFF);
    const int wave0 = __builtin_amdgcn_readfirstlane(threadIdx.x >> 6);
    const int G = gridDim.x; const int bx = blockIdx.x; const int vcu = (G % 8 == 0) ? (bx % 8) * (G / 8) + bx / 8 : bx;
    unsigned char* ws = args.ws;
    gu32* ctl = (gu32*)(ws + WS_CTL);
    for (int u = threadIdx.x; u < 512 / 4; u += NWAVES * 64) ((LAS unsigned*)(lds + LDSCTL_OFF))[u] = 0u;
    __syncthreads();
    XcdBarrier bar = xcd_barrier_post((unsigned*)(ctl + CW_BAR), MISC + 8);
    const int lo = args.ph_lo, hi = args.ph_hi;
#ifndef PH_MASK
#define PH_MASK 0xFFF
#endif
#define IN(k) (((PH_MASK >> (k)) & 1) && lo <= (k) && (k) < hi)
#define SEAM(k) do { if (IN(k) && IN((k) + 1)) xcd_barrier(bar); } while (0)
    bf16* WinT = (bf16*)(ws + WS_WINT); bf16* WpT = (bf16*)(ws + WS_WPT); bf16* WaT = (bf16*)(ws + WS_WAT); bf16* WoT = (bf16*)(ws + WS_WOT); bf16* WrT = (bf16*)(ws + WS_WRT);
    bf16* WguT = (bf16*)(ws + WS_WGUT); bf16* WdT = (bf16*)(ws + WS_WDT);
    bf16* XB = (bf16*)(ws + WS_XB); bf16* Ub = (bf16*)(ws + WS_U); bf16* Qb = (bf16*)(ws + WS_Q); bf16* Kb = (bf16*)(ws + WS_K); bf16* Vb = (bf16*)(ws + WS_V); bf16* Gb = (bf16*)(ws + WS_G);
    bf16* PL = (bf16*)(ws + WS_PL); bf16* ON = (bf16*)(ws + WS_ON); float* STASH = (float*)(ws + WS_STASH);
    bf16* Tb = (bf16*)(ws + WS_T); bf16* MG = (bf16*)(ws + WS_MG); float* Z = (float*)(ws + WS_Z);
    bf16* H1B = (bf16*)(ws + WS_H1B); bf16* YSB = (bf16*)(ws + WS_YSB); float* LOG = (float*)(ws + WS_LOG);
    int* IDX = (int*)(ws + WS_IDX); float* TKW = (float*)(ws + WS_TKW); int* CNT = (int*)(ws + WS_CNT);
    int* RTOK = (int*)(ws + WS_RTOK); float* RW = (float*)(ws + WS_RW); int* RSLOT = (int*)(ws + WS_RSLOT);
    bf16* HID = (bf16*)(ws + WS_HID); bf16* OS = (bf16*)(ws + WS_OS);
    const int NGW = G * NWAVES, NGT = G * NWAVES * 64;
#define PHASE_IDS const int tid = opaque_tid(wave0), lane = tid & 63, wave = __builtin_amdgcn_readfirstlane(tid >> 6), gw = vcu * NWAVES + wave, gt = vcu * (NWAVES * 64) + tid; (void)lane; (void)gw; (void)gt;

    if (IN(0)) { PHASE_IDS
        LAS float* scr = (LAS float*)(lds + RING_OFF + wave * 16384);
        constexpr int I0 = 2048, I1 = I0 + 512, I2 = I1 + 128, I3 = I2 + 257 * 128, I4 = I3 + 257 * 128, I5 = I4 + 257 * 128;
        auto decode = [&](int it) -> TrItem {
            if (it < I0) { const int kb = it / 128, nb = it % 128; return TrItem{args.in[I_WIN] + (size_t)(64 * kb) * INW + 32 * nb, WinT + (size_t)(32 * nb) * DM + 64 * kb, INW, DM, -1}; }
            if (it < I1) { const int r = it - I0, kb = r / 32, nb = r % 32; return TrItem{args.in[I_WOUT] + (size_t)(64 * kb) * DM + 32 * nb, WoT + (size_t)(32 * nb) * DM + 64 * kb, DM, DM, -1}; }
            if (it < I2) { const int r = it - I1, kb = r / 8, nb = r % 8; return TrItem{args.in[I_WR] + (size_t)(64 * kb) * NE + 32 * nb, WrT + (size_t)(32 * nb) * DM + 64 * kb, NE, DM, -1}; }
            if (it < I4) { const bool up = it >= I3; const int r = it - (up ? I3 : I2), e = r / 128, q = r % 128, kb = q / 8, nb = q % 8, n0 = 32 * nb;
                const float* W = e < NE ? args.in[up ? I_WEU : I_WEG] + (size_t)e * DM * ED : args.in[up ? I_WSU : I_WSG];
                const int drow0 = e * 512 + 256 * (n0 >> 7) + (n0 & 127) + (up ? 128 : 0);
                return TrItem{W + (size_t)(64 * kb) * ED + n0, WguT + (size_t)drow0 * DM + 64 * kb, ED, DM, -1}; }
            { const int r = it - I4, e = r / 128, q = r % 128, kb = q / 32, nb = q % 32;
              const float* W = e < NE ? args.in[I_WED] + (size_t)e * ED * DM : args.in[I_WSD];
              const int n0 = 32 * nb, grp = (n0 >> 8) * 256 + ((n0 & 255) >> 6) * 32;
              return TrItem{W + (size_t)(64 * kb) * DM + n0, WdT + (size_t)(e * DM + grp) * ED + 64 * kb, DM, ED, n0 & 63}; }
        };
        { int it = gw; f32x4 va[8], vb[8]; TrItem ta{}, tb{};
          if (it < I5) { ta = decode(it); tr_load(ta, va, lane); }
          while (it < I5) {
              const int itn = it + NGW; if (itn < I5) { tb = decode(itn); tr_load(tb, vb, lane); }
              tr_finish(ta, va, scr, lane);
              it = itn + NGW; if (itn < I5) { if (it < I5) { ta = decode(it); tr_load(ta, va, lane); } tr_finish(tb, vb, scr, lane); }
          } }
        { const float* x = args.in[I_X];
          constexpr size_t NCH = (size_t)M * DM / 8;
          for (size_t i = gt; i < NCH; i += (size_t)NGT * 4) { f32x4 a[4], b[4];
#pragma unroll
              for (int q = 0; q < 4; ++q) { const size_t c = i + (size_t)q * NGT; if (c < NCH) { a[q] = *(const f32x4*)(x + c * 8); b[q] = *(const f32x4*)(x + c * 8 + 4); } }
#pragma unroll
              for (int q = 0; q < 4; ++q) { const size_t c = i + (size_t)q * NGT; if (c < NCH) *(v4u*)(XB + c * 8) = pg8::pack8(a[q], b[q]); } } }
        { const float* wg = args.in[I_WPG]; const float* ps = args.in[I_PSC]; const float* wbp = args.in[I_WBP]; const float* wba = args.in[I_WBA]; const float* sg = args.in[I_SUBG];
          for (int i = gt; i < (PW / 8) * DM; i += NGT) { const int kk0 = (i / DM) * 8, n = i % DM, g = kk0 >> 7;
              float acc[8];
#pragma unroll
              for (int q = 0; q < 8; ++q) acc[q] = 0.f;
#pragma unroll 16
              for (int d = 0; d < 128; ++d) { const float b = wbp[(size_t)(g * 128 + d) * DM + n] * ps[g * 128 + d];
#pragma unroll
                  for (int q = 0; q < 8; ++q) acc[q] += wg[(kk0 + q) * 128 + d] * b; }
              *(v4u*)(WpT + (size_t)n * PW + kk0) = pg8::pack8((f32x4){acc[0], acc[1], acc[2], acc[3]}, (f32x4){acc[4], acc[5], acc[6], acc[7]}); }
          for (int i = gt; i < DM * AW; i += NGT) { const int k = i / DM, n = i % DM; const float s = wba[i] * sg[k & 127] * (1.0f - LAM_INIT);
              WaT[(size_t)n * AW + k] = (bf16)(cvt_pk_bf16(s, 0.f) & 0xffffu); } }
    }
    SEAM(0);

    if (IN(1)) { PHASE_IDS
        pg8::DenseOrder S; S.init(XB, WinT, M, INW, DM, G, bx, DUP(1));
        pg8::EpiInProj E{Ub, Qb, Kb, Vb, Gb, args.in[I_BGATE]};
        pg8::gemm_phase<pg8::EpiInProj, pg8::DenseOrder, false>(lds + RING_OFF, DM, S, E, nullptr, wave0);
    }
    SEAM(1);

    if (IN(2)) { PHASE_IDS
        { const int sub = lane >> 4, ch = lane & 15;
          for (int it = gw; it < M; it += NGW) { const int g = it & 3, tq = it >> 2, t = tq * 4 + sub, sp = t & (SEQ - 1);
              const bf16* base = Ub + (size_t)(t - sp) * PW + g * 128 + ch * 8; bf16* dst = PL + (size_t)t * PW + g * 128 + ch * 8;
              if (g == 0) pool_item<2>(base, sp, dst); else if (g == 1) pool_item<4>(base, sp, dst); else if (g == 2) pool_item<8>(base, sp, dst); else pool_item<16>(base, sp, dst); } }
        LAS char* al = (LAS char*)(lds + RING_OFF);
        LAS float* tab = (LAS float*)(al + att::L_TAB); LAS float* lamp = (LAS float*)(al + att::L_LAM);
        { const float* tbl = args.in[I_RELB];
          for (int i = tid; i < NH * 449; i += NWAVES * 64) { const int h = i / 449, rel = i % 449 - 224; const int n = rel < 0 ? -rel : rel; int bk = rel > 0 ? 16 : 0;
              if (n < 8) bk += n; else { int lg = 31 - __builtin_clz((unsigned)(n * n)) - 6 + 8; bk += lg > 15 ? 15 : lg; }
              tab[h * 452 + (rel + 224)] = tbl[bk * NH + h] * 1.4426950408889634f; }
          if (wave == 0) { const float s1 = wave_sum(args.in[I_LQ1][lane] * args.in[I_LK1][lane]), s2 = wave_sum(args.in[I_LQ2][lane] * args.in[I_LK2][lane]);
              if (lane == 0) lamp[0] = __expf(s1) - __expf(s2) + LAM_INIT; } }
        __syncthreads();
#pragma unroll 1
        for (int pi = 0; pi < 4; ++pi) {
            const int unit = vcu * 4 + pi;
            const int bh = unit >> 6, qb = unit & 63, b = bh >> 2, h = bh & 3, q0 = qb * att::QROWS;
            const size_t rowbase = (size_t)b * SEQ;
            f32x16 o[4]; float l;
            { const int t_ = opaque_tid(wave0), l_ = t_ & 63, w_ = t_ >> 6;
              const bf16* Qw = Qb + (rowbase + q0 + (w_ & 3) * 32 + (l_ & 31)) * 512 + h * 128 + (w_ >> 2) * 64 + (l_ >> 5) * 8;
              att::attn_pass(Qw, Kb + rowbase * 512 + h * 128, Vb + rowbase * 512 + h * 128, q0, al, tab + h * 452, o, l, wave0); }
            asm volatile("" ::: "memory");
            {
                const int t2_ = opaque_tid(wave0), ln = t2_ & 63, wv = __builtin_amdgcn_readfirstlane(t2_ >> 6), r32 = ln & 31, hi2 = ln >> 5, comp = wv >> 2, wq = wv & 3;
                LAS float* wsf = (LAS float*)(al + att::L_WS) + wv * 64;
                LAS float* xch = (LAS float*)(al + att::L_XCH) + wq * 4096 + ln;
                if (hi2 == 0) wsf[r32] = l; LDS_WAIT();
#pragma unroll
                for (int r = 0; r < 16; ++r) { const float rl = __builtin_amdgcn_rcpf(wsf[att::crow(r, hi2)]);
#pragma unroll
                    for (int d = 0; d < 4; ++d) o[d][r] *= rl; }
                if (comp == 1) {
#pragma unroll
                    for (int r = 0; r < 16; ++r) {
#pragma unroll
                        for (int d = 0; d < 4; ++d) xch[(d * 16 + r) * 64] = o[d][r]; }
                }
                __syncthreads();
                if (comp == 0) {
                    const float lam = lamp[0];
                    LAS bf16* st = (LAS bf16*)(al + att::L_STG) + wq * 4096;
#pragma unroll
                    for (int r = 0; r < 16; ++r) { float v[4]; float sq = 0.f;
#pragma unroll
                        for (int d = 0; d < 4; ++d) { v[d] = o[d][r] - lam * xch[(d * 16 + r) * 64]; sq += v[d] * v[d]; }
#pragma unroll
                        for (int off = 1; off < 32; off <<= 1) sq += __shfl_xor(sq, off);
                        const float rs = 1.0f / sqrtf(sq * (1.0f / 128.0f) + LN_EPS); const int orow = att::crow(r, hi2);
#pragma unroll
                        for (int d = 0; d < 4; ++d) st[orow * 128 + d * 32 + r32] = (bf16)(cvt_pk_bf16(v[d] * rs, 0.f) & 0xffffu); }
                    LDS_WAIT();
                    bf16* Ow = ON + (rowbase + q0 + wq * 32) * 512 + h * 128;
#pragma unroll
                    for (int i = 0; i < 8; ++i) { const int p = i * 64 + ln, row = p >> 4, chn = p & 15; const v4u vv = *(const LAS v4u*)(st + row * 128 + chn * 8); *(v4u*)(Ow + (size_t)row * 512 + chn * 8) = vv; }
                }
                __syncthreads();
            }
        }
    }
    SEAM(2);

    if (IN(3)) { PHASE_IDS
        { pg8::DenseOrder S; S.init(PL, WpT, M, DM, PW, G, bx, DUP(3)); pg8::EpiGate<false> E{Gb, 0, nullptr, Tb};
          pg8::gemm_phase<pg8::EpiGate<false>, pg8::DenseOrder, false>(lds + RING_OFF, PW, S, E, nullptr, wave0); }
        { pg8::DenseOrder S; S.init(ON, WaT, M, DM, AW, G, bx, DUP(3)); pg8::EpiGate<true> E{Gb, DM, Tb, MG};
          pg8::gemm_phase<pg8::EpiGate<true>, pg8::DenseOrder, false>(lds + RING_OFF, AW, S, E, nullptr, wave0); }
    }
    SEAM(3);

    if (IN(4)) { PHASE_IDS
        pg8::DenseOrder S; S.init(MG, WoT, M, DM, DM, G, bx, DUP(4)); pg8::EpiResid E{args.in[I_X], Z};
        pg8::gemm_phase<pg8::EpiResid, pg8::DenseOrder, false>(lds + RING_OFF, DM, S, E, nullptr, wave0);
    }
    SEAM(4);

    if (IN(5)) { PHASE_IDS
        const float* gma = args.in[I_LN1G]; const float* bta = args.in[I_LN1B];
        f32x4 gv[4], bv[4];
#pragma unroll
        for (int j = 0; j < 4; ++j) { gv[j] = *(const f32x4*)(gma + 4 * lane + 256 * j); bv[j] = *(const f32x4*)(bta + 4 * lane + 256 * j); }
        for (int m = gw; m < M; m += NGW) {
            const f32x4* xr = (const f32x4*)(Z + (size_t)m * DM) + lane; f32x4 v[4]; float s = 0.f;
#pragma unroll
            for (int j = 0; j < 4; ++j) { v[j] = xr[64 * j]; s += (v[j].x + v[j].y) + (v[j].z + v[j].w); }
            const float mean = wave_sum(s) * (1.f / DM); float s2 = 0.f;
#pragma unroll
            for (int j = 0; j < 4; ++j) { v[j] = v[j] - mean; s2 += (v[j].x * v[j].x + v[j].y * v[j].y) + (v[j].z * v[j].z + v[j].w * v[j].w); }
            const float rstd = 1.f / sqrtf(wave_sum(s2) * (1.f / DM) + LN_EPS);
            v2u* bo = (v2u*)(H1B + (size_t)m * DM) + lane;
#pragma unroll
            for (int j = 0; j < 4; ++j) { const f32x4 y = v[j] * rstd * gv[j] + bv[j]; v2u w; w.x = cvt_pk_bf16(y.x, y.y); w.y = cvt_pk_bf16(y.z, y.w); bo[64 * j] = w; }
        }
        if (bx == 0) { for (int i = tid; i < DM / 2; i += NWAVES * 64) ((unsigned*)(H1B + (size_t)M * DM))[i] = 0u; }
    }
    SEAM(5);

    if (IN(6)) { PHASE_IDS
        pg8::DenseOrder S; S.init(H1B, WrT, M, NE, DM, G, bx, DUP(6)); pg8::EpiLogits E{LOG};
        pg8::gemm_phase<pg8::EpiLogits, pg8::DenseOrder, false>(lds + RING_OFF, DM, S, E, nullptr, wave0);
    }
    SEAM(6);

    const int CH = M / G;
    if (IN(7)) { PHASE_IDS
        LAS int* hist = (LAS int*)(lds + RING_OFF);
        for (int i = tid; i < NE; i += NWAVES * 64) hist[i] = 0;
        __syncthreads();
        const f32x4 rb = *(const f32x4*)(args.in[I_RB] + 4 * lane);
        for (int tt = wave; tt < CH; tt += NWAVES) {
            const int t = bx * CH + tt;
            const f32x4 lg = *(const f32x4*)(LOG + (size_t)t * NE + 4 * lane);
            float s[4], c[4];
#pragma unroll
            for (int j = 0; j < 4; ++j) { s[j] = 1.0f / (1.0f + __expf(-lg[j])); c[j] = s[j] + rb[j]; }
            float m1 = fmaxf(c[0], c[1]), m2 = fminf(c[0], c[1]);
            { const float a = fmaxf(c[2], c[3]), b2 = fminf(c[2], c[3]); const float n1 = fmaxf(m1, a), n2 = fmaxf(fminf(m1, a), fmaxf(m2, b2)); m1 = n1; m2 = n2; }
#define TOP2_MERGE(CTRL) do { const float a1 = dpp_f<CTRL>(m1), a2 = dpp_f<CTRL>(m2); const float n1 = fmaxf(m1, a1), n2 = fmaxf(fminf(m1, a1), fmaxf(m2, a2)); m1 = n1; m2 = n2; } while (0)
            TOP2_MERGE(0xB1); TOP2_MERGE(0x4E); TOP2_MERGE(0x141);
#undef TOP2_MERGE
            const float gs = m1 + m2; const int mygrp = lane >> 3; int rank = 0;
#pragma unroll
            for (int g2 = 0; g2 < 8; ++g2) { const float og = readlane_f(gs, g2 * 8); rank += (og > gs || (og == gs && g2 < mygrp)) ? 1 : 0; }
            if (rank >= 4) {
#pragma unroll
                for (int j = 0; j < 4; ++j) c[j] = -INFINITY; }
            float wsel = 0.f; int isel = 0; float ssum = 0.f;
#pragma unroll 1
            for (int k = 0; k < TOPK; ++k) {
                float bv = c[0]; int bj = 0;
#pragma unroll
                for (int j = 1; j < 4; ++j) if (c[j] > bv) { bv = c[j]; bj = j; }
                const float mx = wave_max_f(bv);
                const unsigned long long msk = __ballot(bv == mx);
                const int wl = (int)__builtin_ctzll(msk);
                const int wj = __builtin_amdgcn_readlane(bj, wl);
                const float s01 = wj & 1 ? s[1] : s[0], s23 = wj & 1 ? s[3] : s[2];
                const float bs = readlane_f(wj & 2 ? s23 : s01, wl);
                if (lane == wl) {
#pragma unroll
                    for (int j = 0; j < 4; ++j) if (wj == j) c[j] = -INFINITY; }
                ssum += bs; if (lane == k) { wsel = bs; isel = wl * 4 + wj; }
            }
            if (lane < TOPK) { IDX[(size_t)t * TOPK + lane] = isel; TKW[(size_t)t * TOPK + lane] = wsel / ssum * ROUTED_SCALE; __hip_atomic_fetch_add(&hist[isel], 1, __ATOMIC_RELAXED, __HIP_MEMORY_SCOPE_WORKGROUP); }
        }
        __syncthreads();
        for (int i = tid; i < NE; i += NWAVES * 64) CNT[bx * NE + i] = hist[i];
        __syncthreads();
    }
    SEAM(7);

    LAS unsigned short* tile_e = (LAS unsigned short*)(lds + LT_TILE_E);
    LAS int* toks = (LAS int*)(lds + LT_TOKS);
    LAS int* ntr_p = (LAS int*)(lds + LT_NTR);
    if (IN(8)) { PHASE_IDS
        build_tables(lds, CNT, G, bx, tid);
        LAS int* tot = (LAS int*)(lds + RING_OFF); LAS int* before = tot + 256; LAS int* tstart = tot + 512; LAS int* lbase = tot + 768; LAS int* lcur = tot + 1024;
        const int NTr = ntr_p[0];
        if (tid < NE) { const int e = tid, ts = tstart[e], nt_ = (tot[e] + 255) >> 8; lbase[e] = ts * 256 + before[e]; lcur[e] = 0;
            if ((e % G) == bx) { for (int r = ts * 256 + tot[e]; r < (ts + nt_) * 256; ++r) { RTOK[r] = M; RW[r] = 0.f; RSLOT[r] = -1; } } }
        __syncthreads();
        for (int a = tid; a < CH * TOPK; a += NWAVES * 64) { const int t = bx * CH + a / TOPK; const int e = IDX[(size_t)bx * CH * TOPK + a]; const float w = TKW[(size_t)bx * CH * TOPK + a];
            const int p = __hip_atomic_fetch_add(&lcur[e], 1, __ATOMIC_RELAXED, __HIP_MEMORY_SCOPE_WORKGROUP); const int dest = lbase[e] + p; RTOK[dest] = t; RW[dest] = w; RSLOT[dest] = bx * CH * TOPK + a; }
        for (int i = tid; i < CH; i += NWAVES * 64) RTOK[NTr * 256 + bx * CH + i] = bx * CH + i;
        __syncthreads();
    }
    SEAM(8);

    if (IN(9)) { PHASE_IDS
        if (!IN(8)) build_tables(lds, CNT, G, bx, tid);
        const int NT = ntr_p[0] + M / 256;
        pg8::ExpertOrder<2, true> S{0, NT, G, vcu, tile_e, (const char*)H1B, (const char*)WguT, (size_t)512 * DM * 2, 0, (size_t)256 * DM * 2, DUP(9)};
        for (int j = 0; j < 8; ++j) { const int rt = S.local(j); if (rt >= 0) for (int i = tid; i < 256; i += NWAVES * 64) toks[j * 256 + i] = RTOK[rt * 256 + i]; }
        __syncthreads();
        pg8::EpiSwiglu E{HID};
        pg8::gemm_phase<pg8::EpiSwiglu, pg8::ExpertOrder<2, true>, true>(lds + RING_OFF, DM, S, E, toks, wave0);
    }
    SEAM(9);

    if (IN(10)) { PHASE_IDS
        if (!IN(8) && !IN(9)) build_tables(lds, CNT, G, bx, tid);
        const int NTr = ntr_p[0], NT = NTr + M / 256;
        { pg8::ExpertOrder<4, false> S{0, NTr, G, vcu, tile_e, (const char*)HID, (const char*)WdT, (size_t)DM * ED * 2, (size_t)256 * ED * 2, (size_t)256 * ED * 2, DUP(10)};
          LAS int* lslot = toks; LAS float* lw = (LAS float*)(lds + LT_ATT);
          for (int j = 0; j < 8; ++j) { const int rt = S.local(j); if (rt >= 0) for (int i = tid; i < 256; i += NWAVES * 64) { lslot[j * 256 + i] = RSLOT[rt * 256 + i]; lw[j * 256 + i] = RW[rt * 256 + i]; } }
          __syncthreads();
          pg8::EpiDownRouted E{OS, lslot, lw};
          pg8::gemm_phase<pg8::EpiDownRouted, pg8::ExpertOrder<4, false>, false>(lds + RING_OFF, ED, S, E, nullptr, wave0); }
        { pg8::ExpertOrder<4, false> S{NTr, NT, G, vcu, tile_e, (const char*)HID, (const char*)WdT, (size_t)DM * ED * 2, (size_t)256 * ED * 2, (size_t)256 * ED * 2, DUP(10)};
          pg8::EpiDownShared E{YSB, NTr * 256};
          pg8::gemm_phase<pg8::EpiDownShared, pg8::ExpertOrder<4, false>, false>(lds + RING_OFF, ED, S, E, nullptr, wave0); }
    }
    SEAM(10);

    if (IN(11)) { PHASE_IDS
        const float* gma = args.in[I_LN2G]; const float* bta = args.in[I_LN2B];
        f32x4 gv[4], bv[4];
#pragma unroll
        for (int j = 0; j < 4; ++j) { const int col = (j >> 1) * 512 + 8 * lane + (j & 1) * 4; gv[j] = *(const f32x4*)(gma + col); bv[j] = *(const f32x4*)(bta + col); }
        unsigned bad = __hip_atomic_load(ctl + CW_BAR + XB_TMO, RLX_AGENT);
        for (int t = gw; t < M; t += NGW) {
            f32x4 v[4];
#pragma unroll
            for (int hf = 0; hf < 2; ++hf) { const size_t o_ = (size_t)t * DM + hf * 512 + 8 * lane; f32x4 h0, h1, y0, y1;
                pg8::unpack8(*(const v4u*)(H1B + o_), h0, h1); pg8::unpack8(*(const v4u*)(YSB + o_), y0, y1); v[2 * hf] = h0 * ALPHA + y0; v[2 * hf + 1] = h1 * ALPHA + y1; }
#pragma unroll
            for (int k = 0; k < TOPK; ++k) { const bf16* rp = OS + ((size_t)t * TOPK + k) * DM + 8 * lane;
                const v4u a = *(const v4u*)rp, b = *(const v4u*)(rp + 512); f32x4 a0, a1, b0, b1; pg8::unpack8(a, a0, a1); pg8::unpack8(b, b0, b1);
                v[0] += a0; v[1] += a1; v[2] += b0; v[3] += b1; }
            float s = 0.f;
#pragma unroll
            for (int j = 0; j < 4; ++j) s += (v[j].x + v[j].y) + (v[j].z + v[j].w);
            const float mean = wave_sum(s) * (1.f / DM); float s2 = 0.f;
#pragma unroll
            for (int j = 0; j < 4; ++j) { v[j] = v[j] - mean; s2 += (v[j].x * v[j].x + v[j].y * v[j].y) + (v[j].z * v[j].z + v[j].w * v[j].w); }
            const float rstd = 1.f / sqrtf(wave_sum(s2) * (1.f / DM) + LN_EPS);
#pragma unroll
            for (int j = 0; j < 4; ++j) { f32x4 y = v[j] * rstd * gv[j] + bv[j]; if (bad) y = (f32x4){__builtin_nanf(""), __builtin_nanf(""), __builtin_nanf(""), __builtin_nanf("")};
                *(f32x4*)(args.out + (size_t)t * DM + (j >> 1) * 512 + 8 * lane + (j & 1) * 4) = y; }
        }
    }
#undef IN
#undef SEAM
}

#ifndef MK_N_LAUNCHES
#define MK_N_LAUNCHES 1
#endif
constexpr int N_PHASES = 12;
extern "C" void kernel_launch(void* const* d_in, const int* in_sizes, int n_in, void* d_out, int out_size, void* d_ws, size_t ws_size, hipStream_t stream) {
    static int grid = 0;
    if (grid == 0) {
        if (n_in != 26 || in_sizes[0] != M * DM || out_size != M * DM || ws_size < WS_END) { fprintf(stderr, "kernel_launch: unexpected shapes (n_in %d, in0 %d, out %d, ws %zu)\n", n_in, n_in > 0 ? in_sizes[0] : -1, out_size, ws_size); grid = -1; return; }
        int dev = 0, cus = 0, per_cu = 0;
        if (hipGetDevice(&dev) != hipSuccess || hipDeviceGetAttribute(&cus, hipDeviceAttributeMultiprocessorCount, dev) != hipSuccess) { grid = -1; return; }
        if (hipFuncSetAttribute((const void*)fwd_kernel, hipFuncAttributeMaxDynamicSharedMemorySize, LDS_BYTES) != hipSuccess) { fprintf(stderr, "kernel_launch: hipFuncSetAttribute failed\n"); grid = -1; return; }
        if (hipOccupancyMaxActiveBlocksPerMultiprocessor(&per_cu, (const void*)fwd_kernel, NWAVES * 64, LDS_BYTES) != hipSuccess || per_cu < 1) { fprintf(stderr, "kernel_launch: occupancy query says %d\n", per_cu); }
        (void)hipGetLastError();
        grid = cus > 256 ? 256 : cus;
        if (grid != 256) { fprintf(stderr, "kernel_launch: this build needs 256 CUs (got %d)\n", cus); grid = -1; return; }
    }
    if (grid < 0) return;
    (void)hipMemsetAsync((char*)d_ws + WS_CTL, 0, CTL_ZERO_BYTES, stream);
    Args a{};
    for (int i = 0; i < 26; ++i) a.in[i] = (const float*)d_in[i];
    a.out = (float*)d_out; a.ws = (unsigned char*)d_ws;
    if (MK_N_LAUNCHES == 1) { a.ph_lo = 0; a.ph_hi = N_PHASES; hipLaunchKernelGGL(fwd_kernel, dim3(grid), dim3(NWAVES * 64), LDS_BYTES, stream, a); }
    else { for (int p = 0; p < N_PHASES; ++p) { a.ph_lo = p; a.ph_hi = p + 1; hipLaunchKernelGGL(fwd_kernel, dim3(grid), dim3(NWAVES * 64), LDS_BYTES, stream, a); } }
    const hipError_t le = hipPeekAtLastError();
    if (le != hipSuccess) fprintf(stderr, "kernel_launch: launch failed: %s\n", hipGetErrorName(le));
}
```

```cpp
#include <hip/hip_runtime.h>
#include <hip/hip_bf16.h>
#include <cstdio>
#include <cstdint>

#define GAS __attribute__((address_space(1)))
#define LAS __attribute__((address_space(3)))
typedef unsigned short bf16;
typedef unsigned v4u __attribute__((ext_vector_type(4)));
typedef unsigned v2u __attribute__((ext_vector_type(2)));
typedef float f32x4 __attribute__((ext_vector_type(4)));
typedef float f32x2 __attribute__((ext_vector_type(2)));
typedef float f32x16 __attribute__((ext_vector_type(16)));
typedef short bf16x8 __attribute__((ext_vector_type(8)));
typedef short s16x4 __attribute__((ext_vector_type(4)));
typedef GAS unsigned gu32;
#define RLX_AGENT __ATOMIC_RELAXED, __HIP_MEMORY_SCOPE_AGENT
#define LDS_WAIT() asm volatile("s_waitcnt lgkmcnt(0)" ::: "memory")
#define VM_WAIT() asm volatile("s_waitcnt vmcnt(0)" ::: "memory")

constexpr int BATCH = 4, SEQ = 8192, DM = 1024, M = BATCH * SEQ;
constexpr int PW = 512, AW = 512, INW = 4096, NH = 4;
constexpr int NE = 256, TOPK = 8, ED = 256;
constexpr float ALPHA = 1.189207115002721f;
constexpr float LN_EPS = 1e-5f, ROUTED_SCALE = 2.5f, LAM_INIT = 0.2f;
constexpr int NTILE_MAX = 1408, RMAX = NTILE_MAX * 256;
constexpr int NWAVES = 8;
#ifndef PROBE_PH
#define PROBE_PH -1
#endif
#define DUP(k) ((k) == PROBE_PH ? 2 : 1)
constexpr float QSCALE = 0.125f * 1.4426950408889634f;

constexpr size_t MiB = 1u << 20;
constexpr size_t WS_CTL = 0, CTL_ZERO_BYTES = 1 * MiB;
constexpr size_t WS_WINT = 1 * MiB, WS_WPT = 9 * MiB, WS_WAT = 10 * MiB, WS_WOT = 11 * MiB, WS_WRT = 13 * MiB;
constexpr size_t WS_IDX = 14 * MiB, WS_TKW = 15 * MiB, WS_CNT = 16 * MiB, WS_RTOK = 17 * MiB, WS_RW = 19 * MiB, WS_RSLOT = 21 * MiB;
constexpr size_t WS_WDT = 24 * MiB;
constexpr size_t WS_H1B = 153 * MiB;
constexpr size_t WS_YSB = 217 * MiB + 4096;
constexpr size_t WS_HID = 281 * MiB;
constexpr size_t WS_WGUT = 457 * MiB;
constexpr size_t WS_OS = 457 * MiB;
constexpr size_t WS_XB = 714 * MiB;
constexpr size_t WS_U = 779 * MiB, WS_Q = 811 * MiB, WS_K = 843 * MiB, WS_V = 875 * MiB;
constexpr size_t WS_G = 281 * MiB;
constexpr size_t WS_PL = 409 * MiB;
constexpr size_t WS_ON = 907 * MiB;
constexpr size_t WS_STASH = 939 * MiB;
constexpr size_t WS_T = 153 * MiB, WS_MG = 217 * MiB + 4096;
constexpr size_t WS_Z = 779 * MiB;
constexpr size_t WS_LOG = 907 * MiB;
constexpr size_t WS_END = 971 * MiB;
constexpr int CW_TMO = 0, CW_CODE = 1, CW_BAR = 4096;

constexpr int RING_OFF = 0, RING_BYTES = 131072;
constexpr int LDSCTL_OFF = RING_BYTES, MISC_OFF = LDSCTL_OFF + 320;
constexpr int LT_TILE_E = LDSCTL_OFF + 512;
constexpr int LT_TOKS = LT_TILE_E + 3072;
constexpr int LT_NTR = LT_TOKS + 8192;
constexpr int LT_ATT = 143360;
constexpr int LDS_BYTES = 155648;
static_assert(LT_NTR + 64 <= LT_ATT && LT_ATT + 2048 + 4 * 452 * 4 + 64 <= LDS_BYTES && LDS_BYTES <= 163840, "LDS map");

__device__ __forceinline__ unsigned cvt_pk_bf16(float lo, float hi) { unsigned r; asm volatile("v_cvt_pk_bf16_f32 %0, %1, %2" : "=v"(r) : "v"(lo), "v"(hi)); return r; }
__device__ __forceinline__ float bf_lo(unsigned w) { return __uint_as_float(w << 16); }
__device__ __forceinline__ float bf_hi(unsigned w) { return __uint_as_float(w & 0xffff0000u); }
__device__ __forceinline__ float wave_sum(float v) {
#pragma unroll
    for (int o = 1; o < 64; o <<= 1) v += __shfl_xor(v, o);
    return v;
}
__device__ __forceinline__ int opaque_tid(int wave0) { int t = (wave0 << 6) | (int)__builtin_amdgcn_mbcnt_hi(~0u, __builtin_amdgcn_mbcnt_lo(~0u, 0u)); asm volatile("" : "+v"(t)); return t; }
__device__ __forceinline__ float sigmoidf_(float x) { return __builtin_amdgcn_rcpf(1.0f + __builtin_amdgcn_exp2f(-1.4426950408889634f * x)); }

namespace pg8 {
constexpr int BM = 256, BK = 64, HALF = 128, HTB = HALF * BK * 2, STAGE_BYTES = 8 * HTB, NXCD = 8, WGM = 8;
__host__ __device__ __forceinline__ int lds_byte(int r, int c) { const int st = (r >> 4) * 2 + (c >> 5), rr = r & 15, cc = c & 31, ob = rr * 64 + cc * 2; return st * 1024 + (ob ^ (((ob >> 9) & 1) << 5)); }
__host__ __device__ __forceinline__ void stage_rc(int b, int& R, int& C) { const int st = b / 1024, sb = b % 1024, swz = sb ^ (((sb >> 9) & 1) << 5); R = (st >> 1) * 16 + swz / 64; C = (st & 1) * 32 + (swz % 64) / 2; }
__host__ __device__ __forceinline__ int perm32(int rho) { const int n = rho >> 4, i = rho & 15; return 8 * (i >> 2) + 4 * n + (i & 3); }

struct Unit { int pm, pn; const char* A; const char* B; int aux, e; };

struct DenseOrder {
    int nM, nN, nwg, G, c, dup; const char* A; const char* Bt; size_t tstep;
    __device__ void init(const void* A_, const void* Bt_, int Mr, int N, int K, int G_, int c_, int dup_ = 1) { dup = dup_; A = (const char*)A_; Bt = (const char*)Bt_; nM = Mr / BM; nN = N / BM; nwg = nM * nN; G = G_; c = c_; tstep = (size_t)BM * K * 2; }
    __device__ bool next(int i, Unit& u) const {
        const long L = (long)(i / dup) * G + c; if (L >= nwg) return false;
        int wgid = (int)L; { const int q = nwg / NXCD, r = nwg % NXCD, xcd = wgid % NXCD, off = wgid / NXCD; wgid = (xcd < r ? xcd * (q + 1) : r * (q + 1) + (xcd - r) * q) + off; }
        const int nig = WGM * nN, gid = wgid / nig, fm = gid * WGM, gsz = (nM - fm) < WGM ? (nM - fm) : WGM;
        u.pm = fm + ((wgid % nig) % gsz); u.pn = (wgid % nig) / gsz; u.A = A + (size_t)u.pm * tstep; u.B = Bt + (size_t)u.pn * tstep; u.aux = 0; u.e = 0; return true;
    }
};
template <int NPN, bool GATHER> struct ExpertOrder {
    int rt0, NT, G, vcu; const LAS unsigned short* tile_e; const char* A; const char* W; size_t wstride, atile, btile; int dup;
    __device__ int nreg() const { return (NT - rt0) / G; }
    __device__ int local(int j) const { const int nr = nreg(); if (j < nr) return rt0 + vcu + j * G;
        const int ru = vcu + (j - nr) * G, RU = ((NT - rt0) - nr * G) * NPN; return ru < RU ? rt0 + nr * G + ru / NPN : -1; }
    __device__ bool next(int i0, Unit& u) const {
        const int i = i0 / dup, nr = nreg(); int j, pn, rt;
        if (i < nr * NPN) { j = i / NPN; pn = i % NPN; rt = rt0 + vcu + j * G; }
        else { const int k = i - nr * NPN, ru = vcu + k * G, RU = ((NT - rt0) - nr * G) * NPN; if (ru >= RU) return false; j = nr + k; rt = rt0 + nr * G + ru / NPN; pn = ru % NPN; }
        const int e = __builtin_amdgcn_readfirstlane((int)tile_e[rt]);
        u.pm = rt; u.pn = pn; u.aux = j; u.e = e; u.A = GATHER ? A : A + (size_t)rt * atile; u.B = W + (size_t)e * wstride + (size_t)pn * btile; return true;
    }
};

__device__ __forceinline__ const char* uptr(const char* p) {
    const unsigned long long v = (unsigned long long)p; const unsigned lo = __builtin_amdgcn_readfirstlane((unsigned)v), hi = __builtin_amdgcn_readfirstlane((unsigned)(v >> 32));
    return (const char*)(((unsigned long long)hi << 32) | lo); }
#define PG8_WAIT_V(n) asm volatile("s_waitcnt vmcnt(" #n ")" ::: "memory")
#define PG8_WAIT_L(n) asm volatile("s_waitcnt lgkmcnt(" #n ")" ::: "memory")
#define PG8_BAR __builtin_amdgcn_s_barrier()
#define PG8_SCHED __builtin_amdgcn_sched_barrier(0)

template <class Epi, class Sched, bool GATHER>
__device__ __forceinline__ void gemm_phase(LAS unsigned char* lds, const int K, const Sched& S, const Epi& E, const LAS int* toks, const int wave0) {
    const int tid = opaque_tid(wave0), wid = __builtin_amdgcn_readfirstlane(tid >> 6), lane = tid & 63, wr = wid >> 2, wc = wid & 3, fr = lane & 15, fq = lane >> 4;
    const int nt = K / BK;
    unsigned voffA[2][2], voffB[2];
#pragma unroll
    for (int i = 0; i < 2; ++i) { int R, C; stage_rc(tid * 16 + i * 8192, R, C); const int Rb = (R & ~31) + perm32(R & 31);
        voffB[i] = (unsigned)(Rb * K + C) * 2u;
        voffA[0][i] = (unsigned)(R * K + C) * 2u; voffA[1][i] = (unsigned)((R + HALF) * K + C) * 2u; }
    const size_t kstep = (size_t)(BK * 2);
    const size_t hstep = (size_t)HALF * K * 2;
    const unsigned ldsw = (unsigned)wid * 1024u;
    const int aoff = lds_byte(wr * 64 + fr, fq * 8), boff = lds_byte(wc * 32 + fr, fq * 8);
#define PG8_SA(b, h) (((b) * 2 + (h)) * HTB)
#define PG8_SB(b, h) ((4 + (b) * 2 + (h)) * HTB)
#define PG8_STAGEA(bufoff, gbase, h) do { _Pragma("unroll") for (int _i = 0; _i < 2; ++_i) { unsigned vo_ = voffA[h][_i]; asm volatile("" : "+v"(vo_)); \
        __builtin_amdgcn_global_load_lds((const unsigned*)((const char*)(gbase) + vo_), (LAS unsigned*)(lds + (bufoff) + ldsw + _i * 8192), 16, 0, 0); } } while (0)
#define PG8_STAGEB(bufoff, gbase) do { _Pragma("unroll") for (int _i = 0; _i < 2; ++_i) { unsigned vo_ = voffB[_i]; asm volatile("" : "+v"(vo_)); \
        __builtin_amdgcn_global_load_lds((const unsigned*)((const char*)(gbase) + vo_), (LAS unsigned*)(lds + (bufoff) + ldsw + _i * 8192), 16, 0, 0); } } while (0)
#define PG8_LDA(dst, b, h) do { _Pragma("unroll") for (int m = 0; m < 4; ++m) _Pragma("unroll") for (int k = 0; k < 2; ++k) dst[m][k] = *(const LAS bf16x8*)(lds + PG8_SA(b, h) + aoff + m * 2048 + k * 1024); } while (0)
#define PG8_LDB(dst, b, h) do { _Pragma("unroll") for (int n = 0; n < 2; ++n) _Pragma("unroll") for (int k = 0; k < 2; ++k) dst[n][k] = *(const LAS bf16x8*)(lds + PG8_SB(b, h) + boff + n * 2048 + k * 1024); } while (0)
#define PG8_MMA(ai, bj, At, Bt) do { __builtin_amdgcn_s_setprio(1); _Pragma("unroll") for (int m = 0; m < 4; ++m) _Pragma("unroll") for (int n = 0; n < 2; ++n) _Pragma("unroll") for (int k = 0; k < 2; ++k) \
        acc[ai][bj][m][n] = __builtin_amdgcn_mfma_f32_16x16x32_bf16(Bt[n][k], At[m][k], acc[ai][bj][m][n], 0, 0, 0); __builtin_amdgcn_s_setprio(0); } while (0)
#define PG8_SETTOK(uu) do { if constexpr (GATHER) { const LAS int* tk_ = toks + (uu).aux * 256; const int t3_ = opaque_tid(wave0); _Pragma("unroll") for (int _i = 0; _i < 2; ++_i) { \
        int R_, C_; stage_rc(t3_ * 16 + _i * 8192, R_, C_); \
        voffA[0][_i] = (unsigned)(tk_[R_] * K + C_) * 2u; voffA[1][_i] = (unsigned)(tk_[R_ + HALF] * K + C_) * 2u; } } } while (0)
    Unit cur, nxt; int ui = 0;
    if (!S.next(0, cur)) return;
    f32x4 acc[2][2][4][2];
#pragma unroll
    for (int a = 0; a < 2; ++a)
#pragma unroll
        for (int b = 0; b < 2; ++b)
#pragma unroll
            for (int m = 0; m < 4; ++m)
#pragma unroll
                for (int n = 0; n < 2; ++n) acc[a][b][m][n] = (f32x4){0.f, 0.f, 0.f, 0.f};
    bf16x8 At[4][2], B0[2][2], B1[2][2];
    const char* cA = uptr(cur.A); const char* cB = uptr(cur.B);
    PG8_SETTOK(cur);
    PG8_STAGEB(PG8_SB(0, 0), cB); PG8_STAGEB(PG8_SB(0, 1), cB + hstep); PG8_STAGEA(PG8_SA(0, 0), cA, 0); PG8_STAGEA(PG8_SA(0, 1), cA, 1);
    if (wr == 1) PG8_BAR;
    PG8_WAIT_V(2); PG8_BAR;
    PG8_STAGEB(PG8_SB(1, 0), cB + kstep); PG8_STAGEA(PG8_SA(1, 0), cA + kstep, 0); PG8_STAGEB(PG8_SB(1, 1), cB + hstep + kstep);
    PG8_WAIT_V(6); PG8_BAR;
    for (;;) {
        const bool has_next = S.next(ui + 1, nxt);
        const char* nA = uptr(has_next ? nxt.A : cA); const char* nB = uptr(has_next ? nxt.B : cB);
        for (int t = 0; t < nt; t += 2) {
            const bool last = (t == nt - 2);
            int tk = t * (BK * 2); asm volatile("" : "+s"(tk));
            const char* a1 = cA + tk + kstep;
            const char* a2 = last ? nA : cA + tk + 2 * kstep; const char* b2 = last ? nB : cB + tk + 2 * kstep;
            const char* a3 = a2 + kstep; const char* b3 = b2 + kstep;
            PG8_LDB(B0, 0, 0); PG8_LDB(B1, 0, 1); PG8_SCHED; PG8_LDA(At, 0, 0); PG8_STAGEA(PG8_SA(1, 1), a1, 1);
            if (GATHER) { if (last && has_next) PG8_SETTOK(nxt); }
            PG8_WAIT_V(8); PG8_WAIT_L(0); PG8_BAR; PG8_MMA(0, 0, At, B0); PG8_MMA(0, 1, At, B1); PG8_BAR; PG8_SCHED;
            PG8_LDA(At, 0, 1); PG8_STAGEB(PG8_SB(0, 0), b2); PG8_STAGEB(PG8_SB(0, 1), b2 + hstep); PG8_STAGEA(PG8_SA(0, 0), a2, 0);
            PG8_WAIT_V(8); PG8_WAIT_L(0); PG8_BAR; PG8_MMA(1, 0, At, B0); PG8_MMA(1, 1, At, B1); PG8_BAR; PG8_SCHED;
            PG8_LDB(B0, 1, 0); PG8_LDB(B1, 1, 1); PG8_SCHED; PG8_LDA(At, 1, 0); PG8_STAGEA(PG8_SA(0, 1), a2, 1);
            PG8_WAIT_V(8); PG8_WAIT_L(0); PG8_BAR; PG8_MMA(0, 0, At, B0); PG8_MMA(0, 1, At, B1); PG8_BAR; PG8_SCHED;
            PG8_LDA(At, 1, 1); PG8_STAGEB(PG8_SB(1, 0), b3); PG8_STAGEB(PG8_SB(1, 1), b3 + hstep); PG8_STAGEA(PG8_SA(1, 0), a3, 0);
            PG8_WAIT_V(8); PG8_WAIT_L(0); PG8_BAR; PG8_MMA(1, 0, At, B0); PG8_MMA(1, 1, At, B1); PG8_BAR; PG8_SCHED;
        }
        if (wr == 0) PG8_BAR;
        { const int l2_ = opaque_tid(wave0) & 63; E(acc, cur, wr, wc, l2_ & 15, l2_ >> 4); }
        if (!has_next) break;
#pragma unroll
        for (int a = 0; a < 2; ++a)
#pragma unroll
            for (int b = 0; b < 2; ++b)
#pragma unroll
                for (int m = 0; m < 4; ++m)
#pragma unroll
                    for (int n = 0; n < 2; ++n) acc[a][b][m][n] = (f32x4){0.f, 0.f, 0.f, 0.f};
        cur = nxt; cA = nA; cB = nB; ++ui;
        if (wr == 1) PG8_BAR;
    }
    PG8_WAIT_V(0);
    PG8_BAR;
#undef PG8_SA
#undef PG8_SB
#undef PG8_STAGEA
#undef PG8_STAGEB
#undef PG8_LDA
#undef PG8_LDB
#undef PG8_MMA
#undef PG8_SETTOK
}

typedef f32x4 Acc[2][2][4][2];
__device__ __forceinline__ v4u pack8(f32x4 v0, f32x4 v1) { v4u w; w.x = cvt_pk_bf16(v0[0], v0[1]); w.y = cvt_pk_bf16(v0[2], v0[3]); w.z = cvt_pk_bf16(v1[0], v1[1]); w.w = cvt_pk_bf16(v1[2], v1[3]); return w; }
__device__ __forceinline__ void unpack8(v4u w, f32x4& v0, f32x4& v1) { v0 = (f32x4){bf_lo(w.x), bf_hi(w.x), bf_lo(w.y), bf_hi(w.y)}; v1 = (f32x4){bf_lo(w.z), bf_hi(w.z), bf_lo(w.w), bf_hi(w.w)}; }

struct EpiInProj {
    bf16 *U, *Q, *Kb, *V, *G; const float* bgate;
    __device__ __forceinline__ void operator()(const Acc& acc, const Unit& u, int wr, int wc, int fr, int fq) const {
        const int row0 = u.pm * BM + wr * 64 + fr; const int colt = u.pn * BM;
        const bool gate = colt >= 2048;
        bf16* base; int ldc, coll;
        if (gate) { base = G; ldc = 2048; coll = colt - 2048; }
        else { const int s = colt >> 9; base = s == 0 ? U : (s == 1 ? Q : (s == 2 ? Kb : V)); ldc = 512; coll = colt & 511; }
        const int col0 = coll + wc * 32 + 8 * fq;
        const float osc = (!gate && (colt >> 9) == 1) ? QSCALE : 1.0f;
        f32x4 bv[2][2];
#pragma unroll
        for (int bj = 0; bj < 2; ++bj)
#pragma unroll
            for (int n = 0; n < 2; ++n) bv[bj][n] = gate ? *(const f32x4*)(bgate + col0 + bj * HALF + 4 * n) : (f32x4){0.f, 0.f, 0.f, 0.f};
#pragma unroll
        for (int ai = 0; ai < 2; ++ai)
#pragma unroll
            for (int m = 0; m < 4; ++m) { bf16* rowp = base + (size_t)(row0 + ai * HALF + m * 16) * ldc + col0;
#pragma unroll
                for (int bj = 0; bj < 2; ++bj) { f32x4 v0 = acc[ai][bj][m][0] + bv[bj][0], v1 = acc[ai][bj][m][1] + bv[bj][1];
                    if (gate) {
#pragma unroll
                        for (int q = 0; q < 4; ++q) { v0[q] = sigmoidf_(v0[q]); v1[q] = sigmoidf_(v1[q]); } }
                    *(v4u*)(rowp + bj * HALF) = pack8(v0 * osc, v1 * osc); } }
    }
};
template <bool ADD> struct EpiGate {
    const bf16* G; int goff; const bf16* Tin; bf16* O;
    __device__ __forceinline__ void operator()(const Acc& acc, const Unit& u, int wr, int wc, int fr, int fq) const {
        const int row0 = u.pm * BM + wr * 64 + fr; const int col0 = u.pn * BM + wc * 32 + 8 * fq;
#pragma unroll
        for (int ai = 0; ai < 2; ++ai)
#pragma unroll
            for (int m = 0; m < 4; ++m) { const size_t row = (size_t)(row0 + ai * HALF + m * 16);
#pragma unroll
                for (int bj = 0; bj < 2; ++bj) { const int col = col0 + bj * HALF;
                    const v4u gw = *(const v4u*)(G + row * 2048 + goff + col); f32x4 g0, g1; unpack8(gw, g0, g1);
                    f32x4 v0 = acc[ai][bj][m][0] * g0, v1 = acc[ai][bj][m][1] * g1;
                    if (ADD) { const v4u tw = *(const v4u*)(Tin + row * DM + col); f32x4 t0, t1; unpack8(tw, t0, t1); v0 += t0; v1 += t1; }
                    *(v4u*)(O + row * DM + col) = pack8(v0, v1); } }
    }
};
struct EpiResid {
    const float* X; float* Z;
    __device__ __forceinline__ void operator()(const Acc& acc, const Unit& u, int wr, int wc, int fr, int fq) const {
        const int row0 = u.pm * BM + wr * 64 + fr; const int col0 = u.pn * BM + wc * 32 + 8 * fq;
#pragma unroll
        for (int ai = 0; ai < 2; ++ai)
#pragma unroll
            for (int m = 0; m < 4; ++m) { const size_t off = (size_t)(row0 + ai * HALF + m * 16) * DM + col0;
#pragma unroll
                for (int bj = 0; bj < 2; ++bj)
#pragma unroll
                    for (int n = 0; n < 2; ++n) { const f32x4 xv = *(const f32x4*)(X + off + bj * HALF + 4 * n); *(f32x4*)(Z + off + bj * HALF + 4 * n) = xv * ALPHA + acc[ai][bj][m][n]; } }
    }
};
struct EpiLogits {
    float* L;
    __device__ __forceinline__ void operator()(const Acc& acc, const Unit& u, int wr, int wc, int fr, int fq) const {
        const int row0 = u.pm * BM + wr * 64 + fr; const int col0 = wc * 32 + 8 * fq;
#pragma unroll
        for (int ai = 0; ai < 2; ++ai)
#pragma unroll
            for (int m = 0; m < 4; ++m) { const size_t off = (size_t)(row0 + ai * HALF + m * 16) * NE + col0;
#pragma unroll
                for (int bj = 0; bj < 2; ++bj)
#pragma unroll
                    for (int n = 0; n < 2; ++n) *(f32x4*)(L + off + bj * HALF + 4 * n) = acc[ai][bj][m][n]; }
    }
};
struct EpiSwiglu {
    bf16* HID;
    __device__ __forceinline__ void operator()(const Acc& acc, const Unit& u, int wr, int wc, int fr, int fq) const {
        const int row0 = u.pm * BM + wr * 64 + fr; const int col0 = u.pn * HALF + wc * 32 + 8 * fq;
#pragma unroll
        for (int ai = 0; ai < 2; ++ai)
#pragma unroll
            for (int m = 0; m < 4; ++m) { f32x4 h[2];
#pragma unroll
                for (int n = 0; n < 2; ++n) { const f32x4 g = acc[ai][0][m][n], up = acc[ai][1][m][n];
#pragma unroll
                    for (int q = 0; q < 4; ++q) h[n][q] = g[q] * sigmoidf_(g[q]) * up[q]; }
                *(v4u*)((char*)HID + (unsigned)((row0 + ai * HALF + m * 16) * ED + col0) * 2u) = pack8(h[0], h[1]); }
    }
};
struct EpiDownRouted {
    bf16* OS; const LAS int* lslot; const LAS float* lw;
    __device__ __forceinline__ void operator()(const Acc& acc, const Unit& u, int wr, int wc, int fr, int fq) const {
        const int col0 = u.pn * BM + wc * 32 + 8 * fq;
#pragma unroll
        for (int ai = 0; ai < 2; ++ai)
#pragma unroll
            for (int m = 0; m < 4; ++m) { const int lr = u.aux * 256 + wr * 64 + fr + ai * HALF + m * 16; const int slot = lslot[lr]; const float w = lw[lr];
                if (slot >= 0) { const unsigned ob = (unsigned)(slot * DM + col0) * 2u;
#pragma unroll
                    for (int bj = 0; bj < 2; ++bj) __builtin_nontemporal_store(pack8(acc[ai][bj][m][0] * w, acc[ai][bj][m][1] * w), (v4u*)((char*)OS + ob + bj * HALF * 2)); } }
    }
};
struct EpiDownShared {
    bf16* YS; int shared_row0;
    __device__ __forceinline__ void operator()(const Acc& acc, const Unit& u, int wr, int wc, int fr, int fq) const {
        const int row0 = u.pm * BM + wr * 64 + fr - shared_row0; const int col0 = u.pn * BM + wc * 32 + 8 * fq;
#pragma unroll
        for (int ai = 0; ai < 2; ++ai)
#pragma unroll
            for (int m = 0; m < 4; ++m) { const unsigned ob = (unsigned)((row0 + ai * HALF + m * 16) * DM + col0) * 2u;
#pragma unroll
                for (int bj = 0; bj < 2; ++bj) *(v4u*)((char*)YS + ob + bj * HALF * 2) = pack8(acc[ai][bj][m][0], acc[ai][bj][m][1]); }
    }
};
}

namespace att {
constexpr int NW = 8, QBLK = 32, KVBLK = 64, PITCH = 512, QROWS = 128;
constexpr float THR2 = 8.f * 1.4426950408889634f;
constexpr int SHM_V = KVBLK * 128 * 2, SHM_K = KVBLK * 128 * 2;
constexpr int NSLOT = 4, L_K = 0, L_V = NSLOT * SHM_K, L_WS = LT_ATT, L_TAB = L_WS + NW * 64 * 4, L_LAM = L_TAB + NH * 452 * 4, L_END = L_LAM + 64;
constexpr int L_XCH = 0, L_STG = 65536;
static_assert(L_STG + 32768 <= 131072 && L_V + NSLOT * SHM_V <= 131072 && L_END <= LDS_BYTES, "attention LDS map");
#define SBAR() __builtin_amdgcn_sched_barrier(0)
#define KSWZ(row, colB) ((row) * 256 + ((colB) ^ (((row) & 7) << 4)))
__device__ __forceinline__ int crow(int r, int hi) { return (r & 3) + 8 * (r >> 2) + 4 * hi; }
__device__ __forceinline__ int v_st(int k, int c) { const int kk = (k & ~0xC) | ((k & 4) << 1) | ((k & 8) >> 1); return ((kk >> 3) * 4 + (c >> 5)) * 512 + ((kk & 7) * 32 + (c & 31)) * 2; }
__device__ __forceinline__ int v_rd_base(int lane) { return ((lane & 3) << 3) | (((lane >> 2) & 3) << 6) | (((lane >> 4) & 1) << 5) | (((lane >> 5) & 1) << 8); }
constexpr int v_rd_off(int d0, int ks, int half) { return d0 * 512 + ks * 4096 + half * 2048; }

__device__ __forceinline__ void partialSM(f32x16& p0, f32x16& p1, float& m_reg, float& alpha, const bool first) {
    float pmax = p0[0];
#pragma unroll
    for (int r = 1; r < 16; ++r) pmax = fmaxf(pmax, p0[r]);
#pragma unroll
    for (int r = 0; r < 16; ++r) pmax = fmaxf(pmax, p1[r]);
    { auto rr = __builtin_amdgcn_permlane32_swap(__float_as_uint(pmax), __float_as_uint(pmax), false, false);
      pmax = fmaxf(__uint_as_float(rr[0]), __uint_as_float(rr[1])); }
    if (__builtin_expect(!first && __all(pmax <= THR2), 1)) { alpha = 1.f; }
    else { const float mn = first ? pmax : fmaxf(pmax, 0.f); alpha = first ? 1.f : __builtin_amdgcn_exp2f(-mn); m_reg += mn;
#pragma unroll
        for (int r = 0; r < 16; ++r) { p0[r] -= mn; p1[r] -= mn; } }
#pragma unroll
    for (int r = 0; r < 16; ++r) p0[r] = __builtin_amdgcn_exp2f(p0[r]);
}
__device__ __forceinline__ void finishSM(f32x16& p0, f32x16& p1, float alpha, float& l_reg, bf16x8& pa0, bf16x8& pa1, bf16x8& pa2, bf16x8& pa3) {
#pragma unroll
    for (int r = 0; r < 16; ++r) p1[r] = __builtin_amdgcn_exp2f(p1[r]);
    float ps = 0;
#pragma unroll
    for (int r = 0; r < 16; ++r) ps += p0[r];
#pragma unroll
    for (int r = 0; r < 16; ++r) ps += p1[r];
    { auto rr = __builtin_amdgcn_permlane32_swap(__float_as_uint(ps), __float_as_uint(ps), false, false);
      ps = __uint_as_float(rr[0]) + __uint_as_float(rr[1]); }
    l_reg = l_reg * alpha + ps;
#define PK4(P, BASE, OUT) do { unsigned a0 = cvt_pk_bf16(P[BASE + 0], P[BASE + 1]), a1 = cvt_pk_bf16(P[BASE + 2], P[BASE + 3]);   \
    unsigned b0 = cvt_pk_bf16(P[BASE + 4], P[BASE + 5]), b1 = cvt_pk_bf16(P[BASE + 6], P[BASE + 7]);                              \
    auto r0 = __builtin_amdgcn_permlane32_swap(a0, b0, false, false); auto r1 = __builtin_amdgcn_permlane32_swap(a1, b1, false, false); \
    v4u w = {r0[0], r1[0], r0[1], r1[1]}; OUT = *reinterpret_cast<bf16x8*>(&w); } while (0)
    PK4(p0, 0, pa0); PK4(p0, 8, pa1); PK4(p1, 0, pa2); PK4(p1, 8, pa3);
#undef PK4
}
__device__ __forceinline__ float fadd_s(float a, float b) { float r; asm("v_add_f32_e32 %0, %1, %2" : "=v"(r) : "v"(a), "v"(b)); return r; }
__device__ __forceinline__ void qkt(f32x16& p0, f32x16& p1, const LAS char* Ks, const bf16x8* qr, int r32, int hi, int kcb, float init) {
#pragma unroll
    for (int r = 0; r < 16; ++r) { p0[r] = init; p1[r] = init; }
#pragma unroll
    for (int d0 = 0; d0 < 4; ++d0) { const int cb = kcb + (d0 * 16 + hi * 8) * 2;
        const bf16x8 b0 = *(const LAS bf16x8*)(Ks + KSWZ(r32, cb));
        const bf16x8 b1 = *(const LAS bf16x8*)(Ks + KSWZ(32 + r32, cb));
        p0 = __builtin_amdgcn_mfma_f32_32x32x16_bf16(b0, qr[d0], p0, 0, 0, 0);
        p1 = __builtin_amdgcn_mfma_f32_32x32x16_bf16(b1, qr[d0], p1, 0, 0, 0); }
}
typedef short v4i16_t __attribute__((ext_vector_type(4)));
__device__ __forceinline__ s16x4 vtr(const LAS char* p) { return __builtin_bit_cast(s16x4, __builtin_amdgcn_ds_read_tr16_b64_v4i16((LAS v4i16_t*)p)); }
__device__ __forceinline__ void pv_d0(f32x16* o, const LAS char* vp, bf16x8 pa0, bf16x8 pa1, bf16x8 pa2, bf16x8 pa3) {
    s16x4 lo[4][4], hi[4][4];
#define PVRD(ks) do { _Pragma("unroll") for (int d0 = 0; d0 < 4; ++d0) { lo[ks][d0] = vtr(vp + v_rd_off(d0, ks, 0)); hi[ks][d0] = vtr(vp + v_rd_off(d0, ks, 1)); } } while (0)
#define PVMM(ks, PA) do { _Pragma("unroll") for (int d0 = 0; d0 < 4; ++d0) o[d0] = __builtin_amdgcn_mfma_f32_32x32x16_bf16(PA, \
        ((bf16x8){lo[ks][d0][0], lo[ks][d0][1], lo[ks][d0][2], lo[ks][d0][3], hi[ks][d0][0], hi[ks][d0][1], hi[ks][d0][2], hi[ks][d0][3]}), o[d0], 0, 0, 0); } while (0)
    PVRD(0); PVRD(1); SBAR();
    PVMM(0, pa0); PVRD(2); SBAR();
    PVMM(1, pa1); PVRD(3); SBAR();
    PVMM(2, pa2); PVMM(3, pa3);
#undef PVRD
#undef PVMM
}

__device__ __forceinline__ void attn_pass(const bf16* __restrict__ Qw, const bf16* __restrict__ Kh, const bf16* __restrict__ Vh, int q0, LAS char* lds, const LAS float* tab,
                                          f32x16 (&o)[4], float& l_out, const int wave0) {
    const int tid = opaque_tid(wave0), wid = __builtin_amdgcn_readfirstlane(tid >> 6), lane = tid & 63, r32 = lane & 31, hi = lane >> 5;
    LAS float* ws = (LAS float*)(lds + L_WS) + wid * 64; LAS float* al_l = ws + 32;
    float m_reg = 0.f, l_reg = 0.f; bf16x8 qr[4];
#pragma unroll
    for (int d = 0; d < 4; ++d) o[d] = (f32x16){0.f, 0.f, 0.f, 0.f, 0.f, 0.f, 0.f, 0.f, 0.f, 0.f, 0.f, 0.f, 0.f, 0.f, 0.f, 0.f};
#pragma unroll
    for (int d0 = 0; d0 < 4; ++d0) qr[d0] = *reinterpret_cast<const bf16x8*>(Qw + d0 * 16);
    unsigned kgo[2], vgo[2];
#pragma unroll
    for (int i = 0; i < 2; ++i) { const int a = (wid * 2 + i) * 1024 + 16 * lane;
        { const int row = a >> 8, cb = (a & 255) ^ ((row & 7) << 4); kgo[i] = (unsigned)(row * PITCH * 2 + cb); }
        { const int sub = a >> 9, w = (a & 511) >> 1, kk = (sub >> 2) * 8 + (w >> 5), k = (kk & ~0xC) | ((kk & 4) << 1) | ((kk & 8) >> 1), c = (sub & 3) * 32 + (w & 31); vgo[i] = (unsigned)(k * PITCH * 2 + c * 2); } }
    const unsigned pw = (unsigned)wid * 2048u;
#define DMA(t, s) do { const char* kt_ = (const char*)(Kh + (size_t)(t) * KVBLK * PITCH); const char* vt_ = (const char*)(Vh + (size_t)(t) * KVBLK * PITCH); \
    _Pragma("unroll") for (int _i = 0; _i < 2; ++_i) { unsigned ko_ = kgo[_i], vo_ = vgo[_i]; asm volatile("" : "+v"(ko_), "+v"(vo_)); \
        __builtin_amdgcn_global_load_lds((const unsigned*)(kt_ + ko_), (LAS unsigned*)(lds + L_K + (s) * SHM_K + pw + _i * 1024), 16, 0, 0); \
        __builtin_amdgcn_global_load_lds((const unsigned*)(vt_ + vo_), (LAS unsigned*)(lds + L_V + (s) * SHM_V + pw + _i * 1024), 16, 0, 0); } } while (0)
    const LAS char* vb0 = lds + L_V + v_rd_base(lane);
    const int kcb = (wid >> 2) * 128;
    const int qwlo = q0 + (wid & 3) * QBLK;
    const int qpos = qwlo + r32;
#define RESC(a) do { if (__any((a) < 1.f)) { if (hi == 0) al_l[r32] = (a); asm volatile("s_waitcnt lgkmcnt(0)" ::: "memory"); \
    _Pragma("unroll") for (int d = 0; d < 4; ++d) _Pragma("unroll") for (int r = 0; r < 16; ++r) o[d][r] *= al_l[crow(r, hi)]; } } while (0)
#define BFAR(k0) (((k0) + 63 - qwlo <= -128) || ((k0) - (qwlo + 31) >= 128))
#define BINIT(k0) ((((k0) + 63 - qwlo <= -128) ? tab[224 - 128] : (((k0) - (qwlo + 31) >= 128) ? tab[224 + 128] : 0.f)) - m_reg)
#define BNEAR(P0, P1, k0) do { if (!BFAR(k0)) { const LAS float* tb_ = tab + ((k0) - qpos + 224 + 4 * hi); \
    _Pragma("unroll") for (int r4 = 0; r4 < 4; ++r4) { \
        _Pragma("unroll") for (int rr = 0; rr < 4; ++rr) { P0[r4 * 4 + rr] += tb_[8 * r4 + rr]; P1[r4 * 4 + rr] += tb_[8 * r4 + rr + 32]; } \
        asm volatile("" ::: "memory"); } } } while (0)
#define WAITBAR(n) asm volatile("s_waitcnt vmcnt(" #n ") lgkmcnt(0)\n\ts_barrier" ::: "memory")
#define KFR(d0, half) (*(const LAS bf16x8*)(ks_ + KSWZ((half) * 32 + r32, kcb + ((d0) * 16 + hi * 8) * 2)))
#define PK4(P, BASE, OUT) do { unsigned a0 = cvt_pk_bf16(P[BASE + 0], P[BASE + 1]), a1 = cvt_pk_bf16(P[BASE + 2], P[BASE + 3]);   \
    unsigned b0 = cvt_pk_bf16(P[BASE + 4], P[BASE + 5]), b1 = cvt_pk_bf16(P[BASE + 6], P[BASE + 7]);                              \
    auto r0 = __builtin_amdgcn_permlane32_swap(a0, b0, false, false); auto r1 = __builtin_amdgcn_permlane32_swap(a1, b1, false, false); \
    v4u w = {r0[0], r1[0], r0[1], r1[1]}; OUT = *reinterpret_cast<bf16x8*>(&w); } while (0)
#define QKFS(P0, P1, Q0, Q1, alQ, Ks, INIT) do { const LAS char* ks_ = (Ks); const float in_ = (INIT); float ps_ = 0.f; \
    const bf16x8 ka0 = KFR(0, 0), kb0 = KFR(0, 1), ka1 = KFR(1, 0), kb1 = KFR(1, 1); \
    _Pragma("unroll") for (int r = 0; r < 16; ++r) { P0[r] = in_; P1[r] = in_; } \
    SBAR(); \
    P0 = __builtin_amdgcn_mfma_f32_32x32x16_bf16(ka0, qr[0], P0, 0, 0, 0); P1 = __builtin_amdgcn_mfma_f32_32x32x16_bf16(kb0, qr[0], P1, 0, 0, 0); \
    const bf16x8 ka2 = KFR(2, 0), kb2 = KFR(2, 1); \
    _Pragma("unroll") for (int r = 0; r < 8; ++r) { Q1[r] = __builtin_amdgcn_exp2f(Q1[r]); ps_ = fadd_s(ps_, Q0[r]); } \
    SBAR(); \
    P0 = __builtin_amdgcn_mfma_f32_32x32x16_bf16(ka1, qr[1], P0, 0, 0, 0); P1 = __builtin_amdgcn_mfma_f32_32x32x16_bf16(kb1, qr[1], P1, 0, 0, 0); \
    const bf16x8 ka3 = KFR(3, 0), kb3 = KFR(3, 1); \
    _Pragma("unroll") for (int r = 8; r < 16; ++r) { Q1[r] = __builtin_amdgcn_exp2f(Q1[r]); ps_ = fadd_s(ps_, Q0[r]); } \
    SBAR(); \
    P0 = __builtin_amdgcn_mfma_f32_32x32x16_bf16(ka2, qr[2], P0, 0, 0, 0); P1 = __builtin_amdgcn_mfma_f32_32x32x16_bf16(kb2, qr[2], P1, 0, 0, 0); \
    float ps2_ = Q1[0]; _Pragma("unroll") for (int r = 1; r < 16; ++r) ps2_ = fadd_s(ps2_, Q1[r]); ps_ = fadd_s(ps_, ps2_); \
    { auto rr = __builtin_amdgcn_permlane32_swap(__float_as_uint(ps_), __float_as_uint(ps_), false, false); ps_ = __uint_as_float(rr[0]) + __uint_as_float(rr[1]); } \
    l_reg = l_reg * (alQ) + ps_; PK4(Q0, 0, pa0); \
    SBAR(); \
    P0 = __builtin_amdgcn_mfma_f32_32x32x16_bf16(ka3, qr[3], P0, 0, 0, 0); P1 = __builtin_amdgcn_mfma_f32_32x32x16_bf16(kb3, qr[3], P1, 0, 0, 0); \
    PK4(Q0, 8, pa1); PK4(Q1, 0, pa2); PK4(Q1, 8, pa3); \
    SBAR(); } while (0)
#define SLOTK(t) (lds + L_K + ((t) & 3) * SHM_K)
#define SLOTV(t) (vb0 + ((t) & 3) * SHM_V)
#define STEP_A(P0, P1, alP, Q0, Q1, alQ, t, more) do { \
    SBAR(); if (more) DMA((t) + 1, ((t) + 1) & 3); SBAR(); \
    QKFS(P0, P1, Q0, Q1, alQ, SLOTK(t), BINIT((t) * KVBLK)); BNEAR(P0, P1, (t) * KVBLK); SBAR(); \
    pv_d0(o, SLOTV((t) - 1), pa0, pa1, pa2, pa3); partialSM(P0, P1, m_reg, alP, false); \
    WAITBAR(0); RESC(alP); } while (0)
#define STEP_B(P0, P1, Q0, Q1, alQ, t, more) do { \
    SBAR(); if (more) DMA((t) + 1, ((t) + 1) & 3); SBAR(); \
    pv_d0(o, SLOTV((t) - 2), pa0, pa1, pa2, pa3); partialSM(Q0, Q1, m_reg, alQ, false); RESC(alQ); SBAR(); \
    QKFS(P0, P1, Q0, Q1, alQ, SLOTK(t), BINIT((t) * KVBLK)); BNEAR(P0, P1, (t) * KVBLK); \
    WAITBAR(0); } while (0)
    f32x16 pA0, pA1, pB0, pB1; float alA = 1.f, alB = 1.f; bf16x8 pa0, pa1, pa2, pa3; constexpr int NT = SEQ / KVBLK;
    DMA(0, 0); DMA(1, 1);
    WAITBAR(4);
    if (wid < 4) {
        qkt(pA0, pA1, SLOTK(0), qr, r32, hi, kcb, BINIT(0)); BNEAR(pA0, pA1, 0); partialSM(pA0, pA1, m_reg, alA, true);
        WAITBAR(0);
        STEP_A(pB0, pB1, alB, pA0, pA1, alA, 1, true);
        for (int t = 2; t + 1 < NT; t += 2) {
            STEP_A(pA0, pA1, alA, pB0, pB1, alB, t, true);
            STEP_A(pB0, pB1, alB, pA0, pA1, alA, t + 1, (t + 2 < NT));
        }
        finishSM(pB0, pB1, alB, l_reg, pa0, pa1, pa2, pa3); SBAR();
        pv_d0(o, SLOTV(NT - 1), pa0, pa1, pa2, pa3);
    } else {
        qkt(pA0, pA1, SLOTK(0), qr, r32, hi, kcb, BINIT(0)); BNEAR(pA0, pA1, 0);
        WAITBAR(0);
        SBAR(); DMA(2, 2); SBAR();
        partialSM(pA0, pA1, m_reg, alA, true); SBAR();
        QKFS(pB0, pB1, pA0, pA1, alA, SLOTK(1), BINIT(KVBLK)); BNEAR(pB0, pB1, KVBLK);
        WAITBAR(0);
        for (int t = 2; t + 1 < NT; t += 2) {
            STEP_B(pA0, pA1, pB0, pB1, alB, t, true);
            STEP_B(pB0, pB1, pA0, pA1, alA, t + 1, (t + 2 < NT));
        }
        pv_d0(o, SLOTV(NT - 2), pa0, pa1, pa2, pa3); partialSM(pB0, pB1, m_reg, alB, false); RESC(alB);
        finishSM(pB0, pB1, alB, l_reg, pa0, pa1, pa2, pa3); SBAR();
        pv_d0(o, SLOTV(NT - 1), pa0, pa1, pa2, pa3);
    }
    l_out = l_reg;
    __syncthreads();
#undef SLOTK
#undef SLOTV
#undef STEP_A
#undef STEP_B
#undef DMA
#undef RESC
#undef BINIT
#undef BFAR
#undef BNEAR
#undef WAITBAR
#undef QKFS
#undef KFR
#undef PK4
}
}

#define XB_TMO      128
#define XB_XCNT(j)  (256  + 64 * (j))
#define XB_XSUB(j)  (1280 + 64 * (j))
#define XB_XGEN(j)  (2304 + 64 * (j))
#define XB_TOP      3328
#define XB_TOPGEN   3392
#define XCD_BAR_WORDS 3456
#define XB_SPIN_CAP (1u << 18)
__device__ __forceinline__ unsigned xb_ld(unsigned* p)              { return __hip_atomic_load(p, __ATOMIC_RELAXED, __HIP_MEMORY_SCOPE_AGENT); }
__device__ __forceinline__ unsigned xb_add(unsigned* p, unsigned v) { return __hip_atomic_fetch_add(p, v, __ATOMIC_RELAXED, __HIP_MEMORY_SCOPE_AGENT); }
__device__ __forceinline__ unsigned xb_xcc_id() { return (unsigned)__builtin_amdgcn_s_getreg((3 << 11) | 20) & 0xFu; }
#define XB_SPIN(cond, bar) do { unsigned _sp = 0; while (cond) { __builtin_amdgcn_s_sleep(1); \
    if ((++_sp & 255u) == 0u) { if (xb_ld(&(bar)[XB_TMO])) break; if (_sp > XB_SPIN_CAP) { atomicAdd(&(bar)[XB_TMO], 1u); break; } } } } while (0)
struct XcdBarrier { unsigned* bar; unsigned x; volatile LAS unsigned* st; };
__device__ __forceinline__ XcdBarrier xcd_barrier_post(unsigned* bar, volatile LAS unsigned* st) {
    XcdBarrier b; b.bar = bar; b.x = xb_xcc_id(); b.st = st;
    if (threadIdx.x == 0) (void)xb_add(&bar[XB_XCNT(b.x)], 1u);
    return b;
}
__device__ __forceinline__ void xcd_barrier_complete(unsigned* bar, unsigned x, unsigned& nloc, unsigned& nx) {
    const unsigned G = gridDim.x * gridDim.y * gridDim.z;
    unsigned sum, cnt, mine, sp = 0u;
    for (;;) {
        sum = 0u; cnt = 0u; mine = 0u;
#pragma unroll
        for (unsigned j = 0; j < 16; ++j) { const unsigned c = xb_ld(&bar[XB_XCNT(j)]); sum += c; cnt += (c > 0u) ? 1u : 0u; mine = (j == x) ? c : mine; }
        if (sum == G) break;
        __builtin_amdgcn_s_sleep(1);
        if ((++sp & 255u) == 0u) { if (xb_ld(&bar[XB_TMO])) break; if (sp > XB_SPIN_CAP) { atomicAdd(&bar[XB_TMO], 1u); break; } }
    }
    nloc = mine > 0u ? mine : 1u; nx = cnt > 0u ? cnt : 1u;
}
__device__ __forceinline__ void xcd_barrier(const XcdBarrier& b) {
    asm volatile("s_waitcnt vmcnt(0)" ::: "memory");
    __syncthreads();
    if (threadIdx.x == 0) {
        unsigned* bar = b.bar;
        __builtin_amdgcn_s_waitcnt(0);
        unsigned nloc = b.st[0], nx = b.st[1];
        if (nloc == 0u) { xcd_barrier_complete(bar, b.x, nloc, nx); b.st[0] = nloc; b.st[1] = nx; }
        const unsigned old = xb_add(&bar[XB_XSUB(b.x)], 1u);
        const unsigned gen = old / nloc;
        if (old + 1u == (gen + 1u) * nloc) {
            __builtin_amdgcn_fence(__ATOMIC_RELEASE, "agent");
            asm volatile("s_waitcnt vmcnt(0)" ::: "memory");
            const unsigned og = xb_add(&bar[XB_TOP], 1u);
            const unsigned tg = og / nx;
            if (og + 1u == (tg + 1u) * nx) xb_add(&bar[XB_TOPGEN], 1u);
            else XB_SPIN(xb_ld(&bar[XB_TOPGEN]) == tg, bar);
            __builtin_amdgcn_fence(__ATOMIC_ACQUIRE, "agent");
            xb_add(&bar[XB_XGEN(b.x)], 1u);
            asm volatile("s_waitcnt vmcnt(0)" ::: "memory");
        } else {
            XB_SPIN(xb_ld(&bar[XB_XGEN(b.x)]) == gen, bar);
            __builtin_amdgcn_fence(__ATOMIC_ACQUIRE, "agent");
            asm volatile("s_waitcnt vmcnt(0)" ::: "memory");
        }
    }
    __syncthreads();
}

struct Args { const float* in[26]; float* out; unsigned char* ws; int ph_lo, ph_hi; };
enum { I_X = 0, I_RELB, I_WIN, I_BGATE, I_WPG, I_PSC, I_WBP, I_LQ1, I_LK1, I_LQ2, I_LK2, I_SUBG, I_WBA, I_WOUT, I_LN1G, I_LN1B, I_WR, I_RB, I_WEG, I_WEU, I_WED, I_WSG, I_WSU, I_WSD, I_LN2G, I_LN2B };

struct TrItem { const float* src; bf16* dst; int ldw, ldt; };
__device__ __forceinline__ void tr_load(const TrItem& t, f32x4 (&v)[8], int lane) {
    const int lr = lane >> 3, lc = (lane & 7) * 4;
#pragma unroll
    for (int j = 0; j < 8; ++j) v[j] = *(const f32x4*)(t.src + (size_t)(lr + 8 * j) * t.ldw + lc);
}
__device__ __forceinline__ void tr_finish(const TrItem& t, const f32x4 (&v)[8], LAS float* scr, int lane) {
    const int lr = lane >> 3, lc = (lane & 7) * 4;
#pragma unroll
    for (int j = 0; j < 8; ++j) { LAS float* d = scr + (lr + 8 * j) * 33 + lc; d[0] = v[j].x; d[1] = v[j].y; d[2] = v[j].z; d[3] = v[j].w; }
    LDS_WAIT(); asm volatile("" ::: "memory");
    const int c = lane & 7;
#pragma unroll
    for (int j = 0; j < 4; ++j) { const int n = (lane >> 3) + 8 * j; const LAS float* s = scr + (8 * c) * 33 + n;
        v4u o; o.x = cvt_pk_bf16(s[0 * 33], s[1 * 33]); o.y = cvt_pk_bf16(s[2 * 33], s[3 * 33]); o.z = cvt_pk_bf16(s[4 * 33], s[5 * 33]); o.w = cvt_pk_bf16(s[6 * 33], s[7 * 33]);
        *(v4u*)(t.dst + (size_t)n * t.ldt + 8 * c) = o; }
    LDS_WAIT(); asm volatile("" ::: "memory");
}

__device__ __forceinline__ float readlane_f(float v, int l) { return __uint_as_float((unsigned)__builtin_amdgcn_readlane((int)__float_as_uint(v), l)); }
template <int CTRL> __device__ __forceinline__ float dpp_f(float v) { return __uint_as_float((unsigned)__builtin_amdgcn_update_dpp((int)__float_as_uint(v), (int)__float_as_uint(v), CTRL, 0xf, 0xf, false)); }
__device__ __forceinline__ float row_max16(float v) {
    v = fmaxf(v, dpp_f<0xB1>(v)); v = fmaxf(v, dpp_f<0x4E>(v)); v = fmaxf(v, dpp_f<0x141>(v)); v = fmaxf(v, dpp_f<0x140>(v)); return v;
}
__device__ __forceinline__ float wave_max_f(float v) {
    v = row_max16(v);
    const float r0 = readlane_f(v, 0), r1 = readlane_f(v, 16), r2 = readlane_f(v, 32), r3 = readlane_f(v, 48);
    return fmaxf(fmaxf(r0, r1), fmaxf(r2, r3));
}
template <int W> __device__ __forceinline__ void pool_item(const bf16* base, int sp, bf16* dst) {
    v4u v[W]; float a[8];
#pragma unroll
    for (int i = 0; i < W; ++i) { int p = sp - W / 2 + i; p = p < 0 ? 0 : (p > SEQ - 1 ? SEQ - 1 : p); v[i] = *(const v4u*)(base + (size_t)p * PW); }
#pragma unroll
    for (int q = 0; q < 8; ++q) a[q] = 0.f;
#pragma unroll
    for (int i = 0; i < W; ++i) { const int p = sp - W / 2 + i; const float m = (p >= 0 && p < SEQ) ? 1.f : 0.f;
        a[0] += m * bf_lo(v[i].x); a[1] += m * bf_hi(v[i].x); a[2] += m * bf_lo(v[i].y); a[3] += m * bf_hi(v[i].y); a[4] += m * bf_lo(v[i].z); a[5] += m * bf_hi(v[i].z); a[6] += m * bf_lo(v[i].w); a[7] += m * bf_hi(v[i].w); }
    int lo_ = sp - W / 2, hi_ = sp + W / 2; lo_ = lo_ < 0 ? 0 : lo_; hi_ = hi_ > SEQ ? SEQ : hi_;
    const float inv = 1.0f / (float)(hi_ - lo_); const v4u sv = v[W / 2];
    const f32x4 r0 = {a[0] * inv - bf_lo(sv.x), a[1] * inv - bf_hi(sv.x), a[2] * inv - bf_lo(sv.y), a[3] * inv - bf_hi(sv.y)};
    const f32x4 r1 = {a[4] * inv - bf_lo(sv.z), a[5] * inv - bf_hi(sv.z), a[6] * inv - bf_lo(sv.w), a[7] * inv - bf_hi(sv.w)};
    *(v4u*)dst = pg8::pack8(r0, r1);
}

__device__ __forceinline__ void build_tables(LAS unsigned char* lds, const int* CNT, int G, int bx, int tid) {
    LAS int* tot = (LAS int*)(lds + RING_OFF); LAS int* before = tot + 256; LAS int* tstart = tot + 512;
    LAS unsigned short* tile_e = (LAS unsigned short*)(lds + LT_TILE_E); LAS int* ntr_p = (LAS int*)(lds + LT_NTR);
    if (tid < NE) { int bsum = 0, tsum = 0;
#pragma unroll 16
        for (int w = 0; w < G; ++w) { const int v = CNT[w * NE + tid]; tsum += v; bsum += (w < bx) ? v : 0; }
        tot[tid] = tsum; before[tid] = bsum; tstart[tid] = (tsum + 255) >> 8; }
    __syncthreads();
    { LAS int* scan2 = tot + 1280; LAS int* src = tstart; LAS int* dst = scan2;
      for (int off = 1; off < NE; off <<= 1) { if (tid < NE) dst[tid] = src[tid] + (tid >= off ? src[tid - off] : 0); __syncthreads(); LAS int* tmp = src; src = dst; dst = tmp; }
      int incl = 0, mine = 0; if (tid < NE) { incl = src[tid]; mine = (tot[tid] + 255) >> 8; }
      __syncthreads();
      if (tid < NE) { tstart[tid] = incl - mine; if (tid == NE - 1) ntr_p[0] = incl; } }
    __syncthreads();
    const int NTr = ntr_p[0];
    if (tid < NE) { const int ts = tstart[tid], nt_ = (tot[tid] + 255) >> 8; for (int i = 0; i < nt_; ++i) tile_e[ts + i] = (unsigned short)tid; }
    for (int i = tid; i < M / 256; i += NWAVES * 64) tile_e[NTr + i] = (unsigned short)NE;
    __syncthreads();
}

__global__ void __launch_bounds__(NWAVES * 64, 2) fwd_kernel(Args args) {
    extern __shared__ __attribute__((aligned(16))) unsigned char lds_raw[];
    LAS unsigned char* lds = (LAS unsigned char*)lds_raw;
    volatile LAS unsigned* MISC = (volatile LAS unsigned*)(lds + MISC_OFF);
    const int wave0 = __builtin_amdgcn_readfirstlane(threadIdx.x >> 6);
    const int G = gridDim.x; const int bx = blockIdx.x; const int vcu = (G % 8 == 0) ? (bx % 8) * (G / 8) + bx / 8 : bx;
    unsigned char* ws = args.ws;
    gu32* ctl = (gu32*)(ws + WS_CTL);
    for (int u = threadIdx.x; u < 512 / 4; u += NWAVES * 64) ((LAS unsigned*)(lds + LDSCTL_OFF))[u] = 0u;
    __syncthreads();
    XcdBarrier bar = xcd_barrier_post((unsigned*)(ctl + CW_BAR), MISC + 8);
    const int lo = args.ph_lo, hi = args.ph_hi;
#ifndef PH_MASK
#define PH_MASK 0xFFF
#endif
#define IN(k) (((PH_MASK >> (k)) & 1) && lo <= (k) && (k) < hi)
#define SEAM(k) do { if (IN(k) && IN((k) + 1)) xcd_barrier(bar); } while (0)
    bf16* WinT = (bf16*)(ws + WS_WINT); bf16* WpT = (bf16*)(ws + WS_WPT); bf16* WaT = (bf16*)(ws + WS_WAT); bf16* WoT = (bf16*)(ws + WS_WOT); bf16* WrT = (bf16*)(ws + WS_WRT);
    bf16* WguT = (bf16*)(ws + WS_WGUT); bf16* WdT = (bf16*)(ws + WS_WDT);
    bf16* XB = (bf16*)(ws + WS_XB); bf16* Ub = (bf16*)(ws + WS_U); bf16* Qb = (bf16*)(ws + WS_Q); bf16* Kb = (bf16*)(ws + WS_K); bf16* Vb = (bf16*)(ws + WS_V); bf16* Gb = (bf16*)(ws + WS_G);
    bf16* PL = (bf16*)(ws + WS_PL); bf16* ON = (bf16*)(ws + WS_ON); float* STASH = (float*)(ws + WS_STASH);
    bf16* Tb = (bf16*)(ws + WS_T); bf16* MG = (bf16*)(ws + WS_MG); float* Z = (float*)(ws + WS_Z);
    bf16* H1B = (bf16*)(ws + WS_H1B); bf16* YSB = (bf16*)(ws + WS_YSB); float* LOG = (float*)(ws + WS_LOG);
    int* IDX = (int*)(ws + WS_IDX); float* TKW = (float*)(ws + WS_TKW); int* CNT = (int*)(ws + WS_CNT);
    int* RTOK = (int*)(ws + WS_RTOK); float* RW = (float*)(ws + WS_RW); int* RSLOT = (int*)(ws + WS_RSLOT);
    bf16* HID = (bf16*)(ws + WS_HID); bf16* OS = (bf16*)(ws + WS_OS);
    const int NGW = G * NWAVES, NGT = G * NWAVES * 64;
#define PHASE_IDS const int tid = opaque_tid(wave0), lane = tid & 63, wave = __builtin_amdgcn_readfirstlane(tid >> 6), gw = vcu * NWAVES + wave, gt = vcu * (NWAVES * 64) + tid; (void)lane; (void)gw; (void)gt;

    if (IN(0)) { PHASE_IDS
        LAS float* scr = (LAS float*)(lds + RING_OFF + wave * 16384);
        constexpr int I0 = 2048, I1 = I0 + 512, I2 = I1 + 128, I3 = I2 + 257 * 128, I4 = I3 + 257 * 128, I5 = I4 + 257 * 128;
        auto decode = [&](int it) -> TrItem {
            if (it < I0) { const int kb = it / 128, nb = it % 128; return TrItem{args.in[I_WIN] + (size_t)(64 * kb) * INW + 32 * nb, WinT + (size_t)(32 * nb) * DM + 64 * kb, INW, DM}; }
            if (it < I1) { const int r = it - I0, kb = r / 32, nb = r % 32; return TrItem{args.in[I_WOUT] + (size_t)(64 * kb) * DM + 32 * nb, WoT + (size_t)(32 * nb) * DM + 64 * kb, DM, DM}; }
            if (it < I2) { const int r = it - I1, kb = r / 8, nb = r % 8; return TrItem{args.in[I_WR] + (size_t)(64 * kb) * NE + 32 * nb, WrT + (size_t)(32 * nb) * DM + 64 * kb, NE, DM}; }
            if (it < I4) { const bool up = it >= I3; const int r = it - (up ? I3 : I2), e = r / 128, q = r % 128, kb = q / 8, nb = q % 8, n0 = 32 * nb;
                const float* W = e < NE ? args.in[up ? I_WEU : I_WEG] + (size_t)e * DM * ED : args.in[up ? I_WSU : I_WSG];
                const int drow0 = e * 512 + 256 * (n0 >> 7) + (n0 & 127) + (up ? 128 : 0);
                return TrItem{W + (size_t)(64 * kb) * ED + n0, WguT + (size_t)drow0 * DM + 64 * kb, ED, DM}; }
            { const int r = it - I4, e = r / 128, q = r % 128, kb = q / 32, nb = q % 32;
              const float* W = e < NE ? args.in[I_WED] + (size_t)e * ED * DM : args.in[I_WSD];
              return TrItem{W + (size_t)(64 * kb) * DM + 32 * nb, WdT + (size_t)(e * DM + 32 * nb) * ED + 64 * kb, DM, ED}; }
        };
        { int it = gw; f32x4 va[8], vb[8]; TrItem ta{}, tb{};
          if (it < I5) { ta = decode(it); tr_load(ta, va, lane); }
          while (it < I5) {
              const int itn = it + NGW; if (itn < I5) { tb = decode(itn); tr_load(tb, vb, lane); }
              tr_finish(ta, va, scr, lane);
              it = itn + NGW; if (itn < I5) { if (it < I5) { ta = decode(it); tr_load(ta, va, lane); } tr_finish(tb, vb, scr, lane); }
          } }
        { const float* x = args.in[I_X];
          constexpr size_t NCH = (size_t)M * DM / 8;
          for (size_t i = gt; i < NCH; i += (size_t)NGT * 4) { f32x4 a[4], b[4];
#pragma unroll
              for (int q = 0; q < 4; ++q) { const size_t c = i + (size_t)q * NGT; if (c < NCH) { a[q] = *(const f32x4*)(x + c * 8); b[q] = *(const f32x4*)(x + c * 8 + 4); } }
#pragma unroll
              for (int q = 0; q < 4; ++q) { const size_t c = i + (size_t)q * NGT; if (c < NCH) *(v4u*)(XB + c * 8) = pg8::pack8(a[q], b[q]); } } }
        { const float* wg = args.in[I_WPG]; const float* ps = args.in[I_PSC]; const float* wbp = args.in[I_WBP]; const float* wba = args.in[I_WBA]; const float* sg = args.in[I_SUBG];
          for (int i = gt; i < (PW / 8) * DM; i += NGT) { const int kk0 = (i / DM) * 8, n = i % DM, g = kk0 >> 7;
              float acc[8];
#pragma unroll
              for (int q = 0; q < 8; ++q) acc[q] = 0.f;
#pragma unroll 16
              for (int d = 0; d < 128; ++d) { const float b = wbp[(size_t)(g * 128 + d) * DM + n] * ps[g * 128 + d];
#pragma unroll
                  for (int q = 0; q < 8; ++q) acc[q] += wg[(kk0 + q) * 128 + d] * b; }
              *(v4u*)(WpT + (size_t)n * PW + kk0) = pg8::pack8((f32x4){acc[0], acc[1], acc[2], acc[3]}, (f32x4){acc[4], acc[5], acc[6], acc[7]}); }
          for (int i = gt; i < DM * AW; i += NGT) { const int k = i / DM, n = i % DM; const float s = wba[i] * sg[k & 127] * (1.0f - LAM_INIT);
              WaT[(size_t)n * AW + k] = (bf16)(cvt_pk_bf16(s, 0.f) & 0xffffu); } }
    }
    SEAM(0);

    if (IN(1)) { PHASE_IDS
        pg8::DenseOrder S; S.init(XB, WinT, M, INW, DM, G, bx, DUP(1));
        pg8::EpiInProj E{Ub, Qb, Kb, Vb, Gb, args.in[I_BGATE]};
        pg8::gemm_phase<pg8::EpiInProj, pg8::DenseOrder, false>(lds + RING_OFF, DM, S, E, nullptr, wave0);
    }
    SEAM(1);

    if (IN(2)) { PHASE_IDS
        { const int sub = lane >> 4, ch = lane & 15;
          for (int it = gw; it < M; it += NGW) { const int g = it & 3, tq = it >> 2, t = tq * 4 + sub, sp = t & (SEQ - 1);
              const bf16* base = Ub + (size_t)(t - sp) * PW + g * 128 + ch * 8; bf16* dst = PL + (size_t)t * PW + g * 128 + ch * 8;
              if (g == 0) pool_item<2>(base, sp, dst); else if (g == 1) pool_item<4>(base, sp, dst); else if (g == 2) pool_item<8>(base, sp, dst); else pool_item<16>(base, sp, dst); } }
        LAS char* al = (LAS char*)(lds + RING_OFF);
        LAS float* tab = (LAS float*)(al + att::L_TAB); LAS float* lamp = (LAS float*)(al + att::L_LAM);
        { const float* tbl = args.in[I_RELB];
          for (int i = tid; i < NH * 449; i += NWAVES * 64) { const int h = i / 449, rel = i % 449 - 224; const int n = rel < 0 ? -rel : rel; int bk = rel > 0 ? 16 : 0;
              if (n < 8) bk += n; else { int lg = 31 - __builtin_clz((unsigned)(n * n)) - 6 + 8; bk += lg > 15 ? 15 : lg; }
              tab[h * 452 + (rel + 224)] = tbl[bk * NH + h] * 1.4426950408889634f; }
          if (wave == 0) { const float s1 = wave_sum(args.in[I_LQ1][lane] * args.in[I_LK1][lane]), s2 = wave_sum(args.in[I_LQ2][lane] * args.in[I_LK2][lane]);
              if (lane == 0) lamp[0] = __expf(s1) - __expf(s2) + LAM_INIT; } }
        __syncthreads();
#pragma unroll 1
        for (int pi = 0; pi < 4; ++pi) {
            const int unit = vcu * 4 + pi;
            const int bh = unit >> 6, qb = unit & 63, b = bh >> 2, h = bh & 3, q0 = qb * att::QROWS;
            const size_t rowbase = (size_t)b * SEQ;
            f32x16 o[4]; float l;
            { const int t_ = opaque_tid(wave0), l_ = t_ & 63, w_ = t_ >> 6;
              const bf16* Qw = Qb + (rowbase + q0 + (w_ & 3) * 32 + (l_ & 31)) * 512 + h * 128 + (w_ >> 2) * 64 + (l_ >> 5) * 8;
              att::attn_pass(Qw, Kb + rowbase * 512 + h * 128, Vb + rowbase * 512 + h * 128, q0, al, tab + h * 452, o, l, wave0); }
            asm volatile("" ::: "memory");
            {
                const int t2_ = opaque_tid(wave0), ln = t2_ & 63, wv = __builtin_amdgcn_readfirstlane(t2_ >> 6), r32 = ln & 31, hi2 = ln >> 5, comp = wv >> 2, wq = wv & 3;
                LAS float* wsf = (LAS float*)(al + att::L_WS) + wv * 64;
                LAS float* xch = (LAS float*)(al + att::L_XCH) + wq * 4096 + ln;
                if (hi2 == 0) wsf[r32] = l; LDS_WAIT();
#pragma unroll
                for (int r = 0; r < 16; ++r) { const float rl = __builtin_amdgcn_rcpf(wsf[att::crow(r, hi2)]);
#pragma unroll
                    for (int d = 0; d < 4; ++d) o[d][r] *= rl; }
                if (comp == 1) {
#pragma unroll
                    for (int r = 0; r < 16; ++r) {
#pragma unroll
                        for (int d = 0; d < 4; ++d) xch[(d * 16 + r) * 64] = o[d][r]; }
                }
                __syncthreads();
                if (comp == 0) {
                    const float lam = lamp[0];
                    LAS bf16* st = (LAS bf16*)(al + att::L_STG) + wq * 4096;
#pragma unroll
                    for (int r = 0; r < 16; ++r) { float v[4]; float sq = 0.f;
#pragma unroll
                        for (int d = 0; d < 4; ++d) { v[d] = o[d][r] - lam * xch[(d * 16 + r) * 64]; sq += v[d] * v[d]; }
#pragma unroll
                        for (int off = 1; off < 32; off <<= 1) sq += __shfl_xor(sq, off);
                        const float rs = 1.0f / sqrtf(sq * (1.0f / 128.0f) + LN_EPS); const int orow = att::crow(r, hi2);
#pragma unroll
                        for (int d = 0; d < 4; ++d) st[orow * 128 + d * 32 + r32] = (bf16)(cvt_pk_bf16(v[d] * rs, 0.f) & 0xffffu); }
                    LDS_WAIT();
                    bf16* Ow = ON + (rowbase + q0 + wq * 32) * 512 + h * 128;
#pragma unroll
                    for (int i = 0; i < 8; ++i) { const int p = i * 64 + ln, row = p >> 4, chn = p & 15; const v4u vv = *(const LAS v4u*)(st + row * 128 + chn * 8); *(v4u*)(Ow + (size_t)row * 512 + chn * 8) = vv; }
                }
                __syncthreads();
            }
        }
    }
    SEAM(2);

    if (IN(3)) { PHASE_IDS
        { pg8::DenseOrder S; S.init(PL, WpT, M, DM, PW, G, bx, DUP(3)); pg8::EpiGate<false> E{Gb, 0, nullptr, Tb};
          pg8::gemm_phase<pg8::EpiGate<false>, pg8::DenseOrder, false>(lds + RING_OFF, PW, S, E, nullptr, wave0); }
        { pg8::DenseOrder S; S.init(ON, WaT, M, DM, AW, G, bx, DUP(3)); pg8::EpiGate<true> E{Gb, DM, Tb, MG};
          pg8::gemm_phase<pg8::EpiGate<true>, pg8::DenseOrder, false>(lds + RING_OFF, AW, S, E, nullptr, wave0); }
    }
    SEAM(3);

    if (IN(4)) { PHASE_IDS
        pg8::DenseOrder S; S.init(MG, WoT, M, DM, DM, G, bx, DUP(4)); pg8::EpiResid E{args.in[I_X], Z};
        pg8::gemm_phase<pg8::EpiResid, pg8::DenseOrder, false>(lds + RING_OFF, DM, S, E, nullptr, wave0);
    }
    SEAM(4);

    if (IN(5)) { PHASE_IDS
        const float* gma = args.in[I_LN1G]; const float* bta = args.in[I_LN1B];
        f32x4 gv[4], bv[4];
#pragma unroll
        for (int j = 0; j < 4; ++j) { gv[j] = *(const f32x4*)(gma + 4 * lane + 256 * j); bv[j] = *(const f32x4*)(bta + 4 * lane + 256 * j); }
        for (int m = gw; m < M; m += NGW) {
            const f32x4* xr = (const f32x4*)(Z + (size_t)m * DM) + lane; f32x4 v[4]; float s = 0.f;
#pragma unroll
            for (int j = 0; j < 4; ++j) { v[j] = xr[64 * j]; s += (v[j].x + v[j].y) + (v[j].z + v[j].w); }
            const float mean = wave_sum(s) * (1.f / DM); float s2 = 0.f;
#pragma unroll
            for (int j = 0; j < 4; ++j) { v[j] = v[j] - mean; s2 += (v[j].x * v[j].x + v[j].y * v[j].y) + (v[j].z * v[j].z + v[j].w * v[j].w); }
            const float rstd = 1.f / sqrtf(wave_sum(s2) * (1.f / DM) + LN_EPS);
            v2u* bo = (v2u*)(H1B + (size_t)m * DM) + lane;
#pragma unroll
            for (int j = 0; j < 4; ++j) { const f32x4 y = v[j] * rstd * gv[j] + bv[j]; v2u w; w.x = cvt_pk_bf16(y.x, y.y); w.y = cvt_pk_bf16(y.z, y.w); bo[64 * j] = w; }
        }
        if (bx == 0) { for (int i = tid; i < DM / 2; i += NWAVES * 64) ((unsigned*)(H1B + (size_t)M * DM))[i] = 0u; }
    }
    SEAM(5);

    if (IN(6)) { PHASE_IDS
        pg8::DenseOrder S; S.init(H1B, WrT, M, NE, DM, G, bx, DUP(6)); pg8::EpiLogits E{LOG};
        pg8::gemm_phase<pg8::EpiLogits, pg8::DenseOrder, false>(lds + RING_OFF, DM, S, E, nullptr, wave0);
    }
    SEAM(6);

    const int CH = M / G;
    if (IN(7)) { PHASE_IDS
        LAS int* hist = (LAS int*)(lds + RING_OFF);
        for (int i = tid; i < NE; i += NWAVES * 64) hist[i] = 0;
        __syncthreads();
        const f32x4 rb = *(const f32x4*)(args.in[I_RB] + 4 * lane);
        for (int tt = wave; tt < CH; tt += NWAVES) {
            const int t = bx * CH + tt;
            const f32x4 lg = *(const f32x4*)(LOG + (size_t)t * NE + 4 * lane);
            float s[4], c[4];
#pragma unroll
            for (int j = 0; j < 4; ++j) { s[j] = 1.0f / (1.0f + __expf(-lg[j])); c[j] = s[j] + rb[j]; }
            float m1 = fmaxf(c[0], c[1]), m2 = fminf(c[0], c[1]);
            { const float a = fmaxf(c[2], c[3]), b2 = fminf(c[2], c[3]); const float n1 = fmaxf(m1, a), n2 = fmaxf(fminf(m1, a), fmaxf(m2, b2)); m1 = n1; m2 = n2; }
#define TOP2_MERGE(CTRL) do { const float a1 = dpp_f<CTRL>(m1), a2 = dpp_f<CTRL>(m2); const float n1 = fmaxf(m1, a1), n2 = fmaxf(fminf(m1, a1), fmaxf(m2, a2)); m1 = n1; m2 = n2; } while (0)
            TOP2_MERGE(0xB1); TOP2_MERGE(0x4E); TOP2_MERGE(0x141);
#undef TOP2_MERGE
            const float gs = m1 + m2; const int mygrp = lane >> 3; int rank = 0;
#pragma unroll
            for (int g2 = 0; g2 < 8; ++g2) { const float og = readlane_f(gs, g2 * 8); rank += (og > gs || (og == gs && g2 < mygrp)) ? 1 : 0; }
            if (rank >= 4) {
#pragma unroll
                for (int j = 0; j < 4; ++j) c[j] = -INFINITY; }
            float wsel = 0.f; int isel = 0; float ssum = 0.f;
#pragma unroll 1
            for (int k = 0; k < TOPK; ++k) {
                float bv = c[0]; int bj = 0;
#pragma unroll
                for (int j = 1; j < 4; ++j) if (c[j] > bv) { bv = c[j]; bj = j; }
                const float mx = wave_max_f(bv);
                const unsigned long long msk = __ballot(bv == mx);
                const int wl = (int)__builtin_ctzll(msk);
                const int wj = __builtin_amdgcn_readlane(bj, wl);
                const float s01 = wj & 1 ? s[1] : s[0], s23 = wj & 1 ? s[3] : s[2];
                const float bs = readlane_f(wj & 2 ? s23 : s01, wl);
                if (lane == wl) {
#pragma unroll
                    for (int j = 0; j < 4; ++j) if (wj == j) c[j] = -INFINITY; }
                ssum += bs; if (lane == k) { wsel = bs; isel = wl * 4 + wj; }
            }
            if (lane < TOPK) { IDX[(size_t)t * TOPK + lane] = isel; TKW[(size_t)t * TOPK + lane] = wsel / ssum * ROUTED_SCALE; __hip_atomic_fetch_add(&hist[isel], 1, __ATOMIC_RELAXED, __HIP_MEMORY_SCOPE_WORKGROUP); }
        }
        __syncthreads();
        for (int i = tid; i < NE; i += NWAVES * 64) CNT[bx * NE + i] = hist[i];
        __syncthreads();
    }
    SEAM(7);

    LAS unsigned short* tile_e = (LAS unsigned short*)(lds + LT_TILE_E);
    LAS int* toks = (LAS int*)(lds + LT_TOKS);
    LAS int* ntr_p = (LAS int*)(lds + LT_NTR);
    if (IN(8)) { PHASE_IDS
        build_tables(lds, CNT, G, bx, tid);
        LAS int* tot = (LAS int*)(lds + RING_OFF); LAS int* before = tot + 256; LAS int* tstart = tot + 512; LAS int* lbase = tot + 768; LAS int* lcur = tot + 1024;
        const int NTr = ntr_p[0];
        if (tid < NE) { const int e = tid, ts = tstart[e], nt_ = (tot[e] + 255) >> 8; lbase[e] = ts * 256 + before[e]; lcur[e] = 0;
            if ((e % G) == bx) { for (int r = ts * 256 + tot[e]; r < (ts + nt_) * 256; ++r) { RTOK[r] = M; RW[r] = 0.f; RSLOT[r] = -1; } } }
        __syncthreads();
        for (int a = tid; a < CH * TOPK; a += NWAVES * 64) { const int t = bx * CH + a / TOPK; const int e = IDX[(size_t)bx * CH * TOPK + a]; const float w = TKW[(size_t)bx * CH * TOPK + a];
            const int p = __hip_atomic_fetch_add(&lcur[e], 1, __ATOMIC_RELAXED, __HIP_MEMORY_SCOPE_WORKGROUP); const int dest = lbase[e] + p; RTOK[dest] = t; RW[dest] = w; RSLOT[dest] = bx * CH * TOPK + a; }
        for (int i = tid; i < CH; i += NWAVES * 64) RTOK[NTr * 256 + bx * CH + i] = bx * CH + i;
        __syncthreads();
    }
    SEAM(8);

    if (IN(9)) { PHASE_IDS
        if (!IN(8)) build_tables(lds, CNT, G, bx, tid);
        const int NT = ntr_p[0] + M / 256;
        pg8::ExpertOrder<2, true> S{0, NT, G, vcu, tile_e, (const char*)H1B, (const char*)WguT, (size_t)512 * DM * 2, 0, (size_t)256 * DM * 2, DUP(9)};
        for (int j = 0; j < 8; ++j) { const int rt = S.local(j); if (rt >= 0) for (int i = tid; i < 256; i += NWAVES * 64) toks[j * 256 + i] = RTOK[rt * 256 + i]; }
        __syncthreads();
        pg8::EpiSwiglu E{HID};
        pg8::gemm_phase<pg8::EpiSwiglu, pg8::ExpertOrder<2, true>, true>(lds + RING_OFF, DM, S, E, toks, wave0);
    }
    SEAM(9);

    if (IN(10)) { PHASE_IDS
        if (!IN(8) && !IN(9)) build_tables(lds, CNT, G, bx, tid);
        const int NTr = ntr_p[0], NT = NTr + M / 256;
        { pg8::ExpertOrder<4, false> S{0, NTr, G, vcu, tile_e, (const char*)HID, (const char*)WdT, (size_t)DM * ED * 2, (size_t)256 * ED * 2, (size_t)256 * ED * 2, DUP(10)};
          LAS int* lslot = toks; LAS float* lw = (LAS float*)(lds + LT_ATT);
          for (int j = 0; j < 8; ++j) { const int rt = S.local(j); if (rt >= 0) for (int i = tid; i < 256; i += NWAVES * 64) { lslot[j * 256 + i] = RSLOT[rt * 256 + i]; lw[j * 256 + i] = RW[rt * 256 + i]; } }
          __syncthreads();
          pg8::EpiDownRouted E{OS, lslot, lw};
          pg8::gemm_phase<pg8::EpiDownRouted, pg8::ExpertOrder<4, false>, false>(lds + RING_OFF, ED, S, E, nullptr, wave0); }
        { pg8::ExpertOrder<4, false> S{NTr, NT, G, vcu, tile_e, (const char*)HID, (const char*)WdT, (size_t)DM * ED * 2, (size_t)256 * ED * 2, (size_t)256 * ED * 2, DUP(10)};
          pg8::EpiDownShared E{YSB, NTr * 256};
          pg8::gemm_phase<pg8::EpiDownShared, pg8::ExpertOrder<4, false>, false>(lds + RING_OFF, ED, S, E, nullptr, wave0); }
    }
    SEAM(10);

    if (IN(11)) { PHASE_IDS
        const float* gma = args.in[I_LN2G]; const float* bta = args.in[I_LN2B];
        f32x4 gv[4], bv[4];
#pragma unroll
        for (int j = 0; j < 4; ++j) { const int col = (j >> 1) * 512 + 8 * lane + (j & 1) * 4; gv[j] = *(const f32x4*)(gma + col); bv[j] = *(const f32x4*)(bta + col); }
        unsigned bad = __hip_atomic_load(ctl + CW_BAR + XB_TMO, RLX_AGENT);
        for (int t = gw; t < M; t += NGW) {
            f32x4 v[4];
#pragma unroll
            for (int hf = 0; hf < 2; ++hf) { const size_t o_ = (size_t)t * DM + hf * 512 + 8 * lane; f32x4 h0, h1, y0, y1;
                pg8::unpack8(*(const v4u*)(H1B + o_), h0, h1); pg8::unpack8(*(const v4u*)(YSB + o_), y0, y1); v[2 * hf] = h0 * ALPHA + y0; v[2 * hf + 1] = h1 * ALPHA + y1; }
#pragma unroll
            for (int k = 0; k < TOPK; ++k) { const bf16* rp = OS + ((size_t)t * TOPK + k) * DM + 8 * lane;
                const v4u a = __builtin_nontemporal_load((const v4u*)rp), b = __builtin_nontemporal_load((const v4u*)(rp + 512)); f32x4 a0, a1, b0, b1; pg8::unpack8(a, a0, a1); pg8::unpack8(b, b0, b1);
                v[0] += a0; v[1] += a1; v[2] += b0; v[3] += b1; }
            float s = 0.f;
#pragma unroll
            for (int j = 0; j < 4; ++j) s += (v[j].x + v[j].y) + (v[j].z + v[j].w);
            const float mean = wave_sum(s) * (1.f / DM); float s2 = 0.f;
#pragma unroll
            for (int j = 0; j < 4; ++j) { v[j] = v[j] - mean; s2 += (v[j].x * v[j].x + v[j].y * v[j].y) + (v[j].z * v[j].z + v[j].w * v[j].w); }
            const float rstd = 1.f / sqrtf(wave_sum(s2) * (1.f / DM) + LN_EPS);
#pragma unroll
            for (int j = 0; j < 4; ++j) { f32x4 y = v[j] * rstd * gv[j] + bv[j]; if (bad) y = (f32x4){__builtin_nanf(""), __builtin_nanf(""), __builtin_nanf(""), __builtin_nanf("")};
                *(f32x4*)(args.out + (size_t)t * DM + (j >> 1) * 512 + 8 * lane + (j & 1) * 4) = y; }
        }
    }
#undef IN
#undef SEAM
}

#ifndef MK_N_LAUNCHES
#define MK_N_LAUNCHES 1
#endif
constexpr int N_PHASES = 12;
extern "C" void kernel_launch(void* const* d_in, const int* in_sizes, int n_in, void* d_out, int out_size, void* d_ws, size_t ws_size, hipStream_t stream) {
    static int grid = 0;
    if (grid == 0) {
        if (n_in != 26 || in_sizes[0] != M * DM || out_size != M * DM || ws_size < WS_END) { fprintf(stderr, "kernel_launch: unexpected shapes (n_in %d, in0 %d, out %d, ws %zu)\n", n_in, n_in > 0 ? in_sizes[0] : -1, out_size, ws_size); grid = -1; return; }
        int dev = 0, cus = 0, per_cu = 0;
        if (hipGetDevice(&dev) != hipSuccess || hipDeviceGetAttribute(&cus, hipDeviceAttributeMultiprocessorCount, dev) != hipSuccess) { grid = -1; return; }
        if (hipFuncSetAttribute((const void*)fwd_kernel, hipFuncAttributeMaxDynamicSharedMemorySize, LDS_BYTES) != hipSuccess) { fprintf(stderr, "kernel_launch: hipFuncSetAttribute failed\n"); grid = -1; return; }
        if (hipOccupancyMaxActiveBlocksPerMultiprocessor(&per_cu, (const void*)fwd_kernel, NWAVES * 64, LDS_BYTES) != hipSuccess || per_cu < 1) { fprintf(stderr, "kernel_launch: occupancy query says %d\n", per_cu); }
        (void)hipGetLastError();
        grid = cus > 256 ? 256 : cus;
        if (grid != 256) { fprintf(stderr, "kernel_launch: this build needs 256 CUs (got %d)\n", cus); grid = -1; return; }
    }
    if (grid < 0) return;
    (void)hipMemsetAsync((char*)d_ws + WS_CTL, 0, CTL_ZERO_BYTES, stream);
    Args a{};
    for (int i = 0; i < 26; ++i) a.in[i] = (const float*)d_in[i];
    a.out = (float*)d_out; a.ws = (unsigned char*)d_ws;
    if (MK_N_LAUNCHES == 1) { a.ph_lo = 0; a.ph_hi = N_PHASES; hipLaunchKernelGGL(fwd_kernel, dim3(grid), dim3(NWAVES * 64), LDS_BYTES, stream, a); }
    else { for (int p = 0; p < N_PHASES; ++p) { a.ph_lo = p; a.ph_hi = p + 1; hipLaunchKernelGGL(fwd_kernel, dim3(grid), dim3(NWAVES * 64), LDS_BYTES, stream, a); } }
    const hipError_t le = hipPeekAtLastError();
    if (le != hipSuccess) fprintf(stderr, "kernel_launch: launch failed: %s\n", hipGetErrorName(le));
}
```

```cpp
#include <hip/hip_runtime.h>
#include <hip/hip_bf16.h>
#include <cstdio>
#include <cstdint>

#define GAS __attribute__((address_space(1)))
#define LAS __attribute__((address_space(3)))
typedef unsigned short bf16;
typedef unsigned v4u __attribute__((ext_vector_type(4)));
typedef unsigned v2u __attribute__((ext_vector_type(2)));
typedef float f32x4 __attribute__((ext_vector_type(4)));
typedef float f32x2 __attribute__((ext_vector_type(2)));
typedef float f32x16 __attribute__((ext_vector_type(16)));
typedef short bf16x8 __attribute__((ext_vector_type(8)));
typedef short s16x4 __attribute__((ext_vector_type(4)));
typedef GAS unsigned gu32;
#define RLX_AGENT __ATOMIC_RELAXED, __HIP_MEMORY_SCOPE_AGENT
#define LDS_WAIT() asm volatile("s_waitcnt lgkmcnt(0)" ::: "memory")
#define VM_WAIT() asm volatile("s_waitcnt vmcnt(0)" ::: "memory")

constexpr int BATCH = 4, SEQ = 8192, DM = 1024, M = BATCH * SEQ;
constexpr int PW = 512, AW = 512, INW = 4096, NH = 4;
constexpr int NE = 256, TOPK = 8, ED = 256;
constexpr float ALPHA = 1.189207115002721f;
constexpr float LN_EPS = 1e-5f, ROUTED_SCALE = 2.5f, LAM_INIT = 0.2f;
constexpr int NTILE_MAX = 1408, RMAX = NTILE_MAX * 256;
constexpr int NWAVES = 8;
#ifndef PROBE_PH
#define PROBE_PH -1
#endif
#define DUP(k) ((k) == PROBE_PH ? 2 : 1)
constexpr float OSCALE = 8.0f;
constexpr float QSCALE = 0.125f * 1.4426950408889634f;

constexpr size_t MiB = 1u << 20;
constexpr size_t WS_CTL = 0, CTL_ZERO_BYTES = 1 * MiB;
constexpr size_t WS_WINT = 1 * MiB, WS_WPT = 9 * MiB, WS_WAT = 10 * MiB, WS_WOT = 11 * MiB, WS_WRT = 13 * MiB;
constexpr size_t WS_IDX = 14 * MiB, WS_TKW = 15 * MiB, WS_CNT = 16 * MiB, WS_RTOK = 17 * MiB, WS_RW = 19 * MiB, WS_RSLOT = 21 * MiB;
constexpr size_t WS_WDT = 24 * MiB;
constexpr size_t WS_H1B = 153 * MiB;
constexpr size_t WS_YSB = 217 * MiB + 4096;
constexpr size_t WS_HID = 281 * MiB;
constexpr size_t WS_WGUT = 457 * MiB;
constexpr size_t WS_OS = 457 * MiB;
constexpr size_t WS_XB = 714 * MiB;
constexpr size_t WS_U = 779 * MiB, WS_Q = 811 * MiB, WS_K = 843 * MiB, WS_V = 875 * MiB;
constexpr size_t WS_G = 281 * MiB;
constexpr size_t WS_PL = 409 * MiB;
constexpr size_t WS_ON = 907 * MiB;
constexpr size_t WS_STASH = 939 * MiB;
constexpr size_t WS_T = 153 * MiB, WS_MG = 217 * MiB + 4096;
constexpr size_t WS_Z = 779 * MiB;
constexpr size_t WS_LOG = 907 * MiB;
constexpr size_t WS_END = 971 * MiB;
constexpr int CW_TMO = 0, CW_CODE = 1, CW_BAR = 4096;

constexpr int RING_OFF = 0, RING_BYTES = 131072;
constexpr int LDSCTL_OFF = RING_BYTES, MISC_OFF = LDSCTL_OFF + 320;
constexpr int LT_TILE_E = LDSCTL_OFF + 512;
constexpr int LT_TOKS = LT_TILE_E + 3072;
constexpr int LT_NTR = LT_TOKS + 8192;
constexpr int LT_ATT = 143360;
constexpr int LDS_BYTES = 155648;
static_assert(LT_NTR + 64 <= LT_ATT && LT_ATT + 2048 + 4 * 452 * 4 + 64 <= LDS_BYTES && LDS_BYTES <= 163840, "LDS map");

__device__ __forceinline__ unsigned cvt_pk_bf16(float lo, float hi) { unsigned r; asm volatile("v_cvt_pk_bf16_f32 %0, %1, %2" : "=v"(r) : "v"(lo), "v"(hi)); return r; }
__device__ __forceinline__ float bf_lo(unsigned w) { return __uint_as_float(w << 16); }
__device__ __forceinline__ float bf_hi(unsigned w) { return __uint_as_float(w & 0xffff0000u); }
__device__ __forceinline__ float wave_sum(float v) {
#pragma unroll
    for (int o = 1; o < 64; o <<= 1) v += __shfl_xor(v, o);
    return v;
}
__device__ __forceinline__ int opaque_tid(int wave0) { int t = (wave0 << 6) | (int)__builtin_amdgcn_mbcnt_hi(~0u, __builtin_amdgcn_mbcnt_lo(~0u, 0u)); asm volatile("" : "+v"(t)); return t; }
__device__ __forceinline__ float sigmoidf_(float x) { return __builtin_amdgcn_rcpf(1.0f + __builtin_amdgcn_exp2f(-1.4426950408889634f * x)); }

namespace pg8 {
constexpr int BM = 256, BK = 64, HALF = 128, HTB = HALF * BK * 2, STAGE_BYTES = 8 * HTB, NXCD = 8, WGM = 8;
__host__ __device__ __forceinline__ int lds_byte(int r, int c) { const int st = (r >> 4) * 2 + (c >> 5), rr = r & 15, cc = c & 31, ob = rr * 64 + cc * 2; return st * 1024 + (ob ^ (((ob >> 9) & 1) << 5)); }
__host__ __device__ __forceinline__ void stage_rc(int b, int& R, int& C) { const int st = b / 1024, sb = b % 1024, swz = sb ^ (((sb >> 9) & 1) << 5); R = (st >> 1) * 16 + swz / 64; C = (st & 1) * 32 + (swz % 64) / 2; }
__host__ __device__ __forceinline__ int perm32(int rho) { const int n = rho >> 4, i = rho & 15; return 8 * (i >> 2) + 4 * n + (i & 3); }

struct Unit { int pm, pn; const char* A; const char* B; int aux, e; };

struct DenseOrder {
    int nM, nN, nwg, G, c, dup; const char* A; const char* Bt; size_t tstep;
    __device__ void init(const void* A_, const void* Bt_, int Mr, int N, int K, int G_, int c_, int dup_ = 1) { dup = dup_; A = (const char*)A_; Bt = (const char*)Bt_; nM = Mr / BM; nN = N / BM; nwg = nM * nN; G = G_; c = c_; tstep = (size_t)BM * K * 2; }
    __device__ bool next(int i, Unit& u) const {
        const long L = (long)(i / dup) * G + c; if (L >= nwg) return false;
        int wgid = (int)L; { const int q = nwg / NXCD, r = nwg % NXCD, xcd = wgid % NXCD, off = wgid / NXCD; wgid = (xcd < r ? xcd * (q + 1) : r * (q + 1) + (xcd - r) * q) + off; }
        const int nig = WGM * nN, gid = wgid / nig, fm = gid * WGM, gsz = (nM - fm) < WGM ? (nM - fm) : WGM;
        u.pm = fm + ((wgid % nig) % gsz); u.pn = (wgid % nig) / gsz; u.A = A + (size_t)u.pm * tstep; u.B = Bt + (size_t)u.pn * tstep; u.aux = 0; u.e = 0; return true;
    }
};
template <int NPN, bool GATHER> struct ExpertOrder {
    int rt0, NT, G, vcu; const LAS unsigned short* tile_e; const char* A; const char* W; size_t wstride, atile, btile; int dup;
    __device__ int nreg() const { return (NT - rt0) / G; }
    __device__ int local(int j) const { const int nr = nreg(); if (j < nr) return rt0 + vcu + j * G;
        const int ru = vcu + (j - nr) * G, RU = ((NT - rt0) - nr * G) * NPN; return ru < RU ? rt0 + nr * G + ru / NPN : -1; }
    __device__ bool next(int i0, Unit& u) const {
        const int i = i0 / dup, nr = nreg(); int j, pn, rt;
        if (i < nr * NPN) { j = i / NPN; pn = i % NPN; rt = rt0 + vcu + j * G; }
        else { const int k = i - nr * NPN, ru = vcu + k * G, RU = ((NT - rt0) - nr * G) * NPN; if (ru >= RU) return false; j = nr + k; rt = rt0 + nr * G + ru / NPN; pn = ru % NPN; }
        const int e = __builtin_amdgcn_readfirstlane((int)tile_e[rt]);
        u.pm = rt; u.pn = pn; u.aux = j; u.e = e; u.A = GATHER ? A : A + (size_t)rt * atile; u.B = W + (size_t)e * wstride + (size_t)pn * btile; return true;
    }
};

__device__ __forceinline__ const char* uptr(const char* p) {
    const unsigned long long v = (unsigned long long)p; const unsigned lo = __builtin_amdgcn_readfirstlane((unsigned)v), hi = __builtin_amdgcn_readfirstlane((unsigned)(v >> 32));
    return (const char*)(((unsigned long long)hi << 32) | lo); }
#define PG8_WAIT_V(n) asm volatile("s_waitcnt vmcnt(" #n ")" ::: "memory")
#define PG8_WAIT_L(n) asm volatile("s_waitcnt lgkmcnt(" #n ")" ::: "memory")
#define PG8_BAR __builtin_amdgcn_s_barrier()
#define PG8_SCHED __builtin_amdgcn_sched_barrier(0)

template <class Epi, class Sched, bool GATHER>
__device__ __forceinline__ void gemm_phase(LAS unsigned char* lds, const int K, const Sched& S, const Epi& E, const LAS int* toks, const int wave0) {
    const int tid = opaque_tid(wave0), wid = __builtin_amdgcn_readfirstlane(tid >> 6), lane = tid & 63, wr = wid >> 2, wc = wid & 3, fr = lane & 15, fq = lane >> 4;
    const int nt = K / BK;
    unsigned voffA[2][2], voffB[2];
#pragma unroll
    for (int i = 0; i < 2; ++i) { int R, C; stage_rc(tid * 16 + i * 8192, R, C); const int Rb = (R & ~31) + perm32(R & 31);
        voffB[i] = (unsigned)(Rb * K + C) * 2u;
        voffA[0][i] = (unsigned)(R * K + C) * 2u; voffA[1][i] = (unsigned)((R + HALF) * K + C) * 2u; }
    const size_t kstep = (size_t)(BK * 2);
    const size_t hstep = (size_t)HALF * K * 2;
    const unsigned ldsw = (unsigned)wid * 1024u;
    const int aoff = lds_byte(wr * 64 + fr, fq * 8), boff = lds_byte(wc * 32 + fr, fq * 8);
#define PG8_SA(b, h) (((b) * 2 + (h)) * HTB)
#define PG8_SB(b, h) ((4 + (b) * 2 + (h)) * HTB)
#define PG8_STAGEA(bufoff, gbase, h) do { _Pragma("unroll") for (int _i = 0; _i < 2; ++_i) { unsigned vo_ = voffA[h][_i]; asm volatile("" : "+v"(vo_)); \
        __builtin_amdgcn_global_load_lds((const unsigned*)((const char*)(gbase) + vo_), (LAS unsigned*)(lds + (bufoff) + ldsw + _i * 8192), 16, 0, 0); } } while (0)
#define PG8_STAGEB(bufoff, gbase) do { _Pragma("unroll") for (int _i = 0; _i < 2; ++_i) { unsigned vo_ = voffB[_i]; asm volatile("" : "+v"(vo_)); \
        __builtin_amdgcn_global_load_lds((const unsigned*)((const char*)(gbase) + vo_), (LAS unsigned*)(lds + (bufoff) + ldsw + _i * 8192), 16, 0, 0); } } while (0)
#define PG8_LDA(dst, b, h) do { _Pragma("unroll") for (int m = 0; m < 4; ++m) _Pragma("unroll") for (int k = 0; k < 2; ++k) dst[m][k] = *(const LAS bf16x8*)(lds + PG8_SA(b, h) + aoff + m * 2048 + k * 1024); } while (0)
#define PG8_LDB(dst, b, h) do { _Pragma("unroll") for (int n = 0; n < 2; ++n) _Pragma("unroll") for (int k = 0; k < 2; ++k) dst[n][k] = *(const LAS bf16x8*)(lds + PG8_SB(b, h) + boff + n * 2048 + k * 1024); } while (0)
#define PG8_MMA(ai, bj, At, Bt) do { __builtin_amdgcn_s_setprio(1); _Pragma("unroll") for (int m = 0; m < 4; ++m) _Pragma("unroll") for (int n = 0; n < 2; ++n) _Pragma("unroll") for (int k = 0; k < 2; ++k) \
        acc[ai][bj][m][n] = __builtin_amdgcn_mfma_f32_16x16x32_bf16(Bt[n][k], At[m][k], acc[ai][bj][m][n], 0, 0, 0); __builtin_amdgcn_s_setprio(0); } while (0)
#define PG8_SETTOK(uu) do { if constexpr (GATHER) { const LAS int* tk_ = toks + (uu).aux * 256; const int t3_ = opaque_tid(wave0); _Pragma("unroll") for (int _i = 0; _i < 2; ++_i) { \
        int R_, C_; stage_rc(t3_ * 16 + _i * 8192, R_, C_); \
        voffA[0][_i] = (unsigned)(tk_[R_] * K + C_) * 2u; voffA[1][_i] = (unsigned)(tk_[R_ + HALF] * K + C_) * 2u; } } } while (0)
    Unit cur, nxt; int ui = 0;
    if (!S.next(0, cur)) return;
    f32x4 acc[2][2][4][2];
#pragma unroll
    for (int a = 0; a < 2; ++a)
#pragma unroll
        for (int b = 0; b < 2; ++b)
#pragma unroll
            for (int m = 0; m < 4; ++m)
#pragma unroll
                for (int n = 0; n < 2; ++n) acc[a][b][m][n] = (f32x4){0.f, 0.f, 0.f, 0.f};
    bf16x8 At[4][2], B0[2][2], B1[2][2];
    const char* cA = uptr(cur.A); const char* cB = uptr(cur.B);
    PG8_SETTOK(cur);
    PG8_STAGEB(PG8_SB(0, 0), cB); PG8_STAGEB(PG8_SB(0, 1), cB + hstep); PG8_STAGEA(PG8_SA(0, 0), cA, 0); PG8_STAGEA(PG8_SA(0, 1), cA, 1);
    if (wr == 1) PG8_BAR;
    PG8_WAIT_V(2); PG8_BAR;
    PG8_STAGEB(PG8_SB(1, 0), cB + kstep); PG8_STAGEA(PG8_SA(1, 0), cA + kstep, 0); PG8_STAGEB(PG8_SB(1, 1), cB + hstep + kstep);
    PG8_WAIT_V(6); PG8_BAR;
    for (;;) {
        const bool has_next = S.next(ui + 1, nxt);
        const char* nA = uptr(has_next ? nxt.A : cA); const char* nB = uptr(has_next ? nxt.B : cB);
        for (int t = 0; t < nt; t += 2) {
            const bool last = (t == nt - 2);
            int tk = t * (BK * 2); asm volatile("" : "+s"(tk));
            const char* a1 = cA + tk + kstep;
            const char* a2 = last ? nA : cA + tk + 2 * kstep; const char* b2 = last ? nB : cB + tk + 2 * kstep;
            const char* a3 = a2 + kstep; const char* b3 = b2 + kstep;
            PG8_LDB(B0, 0, 0); PG8_LDB(B1, 0, 1); PG8_SCHED; PG8_LDA(At, 0, 0); PG8_STAGEA(PG8_SA(1, 1), a1, 1);
            if (GATHER) { if (last && has_next) PG8_SETTOK(nxt); }
            PG8_WAIT_V(8); PG8_WAIT_L(0); PG8_BAR; PG8_MMA(0, 0, At, B0); PG8_MMA(0, 1, At, B1); PG8_BAR; PG8_SCHED;
            PG8_LDA(At, 0, 1); PG8_STAGEB(PG8_SB(0, 0), b2); PG8_STAGEB(PG8_SB(0, 1), b2 + hstep); PG8_STAGEA(PG8_SA(0, 0), a2, 0);
            PG8_WAIT_V(8); PG8_WAIT_L(0); PG8_BAR; PG8_MMA(1, 0, At, B0); PG8_MMA(1, 1, At, B1); PG8_BAR; PG8_SCHED;
            PG8_LDB(B0, 1, 0); PG8_LDB(B1, 1, 1); PG8_SCHED; PG8_LDA(At, 1, 0); PG8_STAGEA(PG8_SA(0, 1), a2, 1);
            PG8_WAIT_V(8); PG8_WAIT_L(0); PG8_BAR; PG8_MMA(0, 0, At, B0); PG8_MMA(0, 1, At, B1); PG8_BAR; PG8_SCHED;
            PG8_LDA(At, 1, 1); PG8_STAGEB(PG8_SB(1, 0), b3); PG8_STAGEB(PG8_SB(1, 1), b3 + hstep); PG8_STAGEA(PG8_SA(1, 0), a3, 0);
            PG8_WAIT_V(8); PG8_WAIT_L(0); PG8_BAR; PG8_MMA(1, 0, At, B0); PG8_MMA(1, 1, At, B1); PG8_BAR; PG8_SCHED;
        }
        if (wr == 0) PG8_BAR;
        { const int l2_ = opaque_tid(wave0) & 63; E(acc, cur, wr, wc, l2_ & 15, l2_ >> 4); }
        if (!has_next) break;
#pragma unroll
        for (int a = 0; a < 2; ++a)
#pragma unroll
            for (int b = 0; b < 2; ++b)
#pragma unroll
                for (int m = 0; m < 4; ++m)
#pragma unroll
                    for (int n = 0; n < 2; ++n) acc[a][b][m][n] = (f32x4){0.f, 0.f, 0.f, 0.f};
        cur = nxt; cA = nA; cB = nB; ++ui;
        if (wr == 1) PG8_BAR;
    }
    PG8_WAIT_V(0);
    PG8_BAR;
#undef PG8_SA
#undef PG8_SB
#undef PG8_STAGEA
#undef PG8_STAGEB
#undef PG8_LDA
#undef PG8_LDB
#undef PG8_MMA
#undef PG8_SETTOK
}

typedef f32x4 Acc[2][2][4][2];
__device__ __forceinline__ v4u pack8(f32x4 v0, f32x4 v1) { v4u w; w.x = cvt_pk_bf16(v0[0], v0[1]); w.y = cvt_pk_bf16(v0[2], v0[3]); w.z = cvt_pk_bf16(v1[0], v1[1]); w.w = cvt_pk_bf16(v1[2], v1[3]); return w; }
__device__ __forceinline__ void unpack8(v4u w, f32x4& v0, f32x4& v1) { v0 = (f32x4){bf_lo(w.x), bf_hi(w.x), bf_lo(w.y), bf_hi(w.y)}; v1 = (f32x4){bf_lo(w.z), bf_hi(w.z), bf_lo(w.w), bf_hi(w.w)}; }

struct EpiInProj {
    bf16 *U, *Q, *Kb, *V, *G; const float* bgate;
    __device__ __forceinline__ void operator()(const Acc& acc, const Unit& u, int wr, int wc, int fr, int fq) const {
        const int row0 = u.pm * BM + wr * 64 + fr; const int colt = u.pn * BM;
        const bool gate = colt >= 2048;
        bf16* base; int ldc, coll;
        if (gate) { base = G; ldc = 2048; coll = colt - 2048; }
        else { const int s = colt >> 9; base = s == 0 ? U : (s == 1 ? Q : (s == 2 ? Kb : V)); ldc = 512; coll = colt & 511; }
        const int col0 = coll + wc * 32 + 8 * fq;
        const float osc = (!gate && (colt >> 9) == 1) ? QSCALE : 1.0f;
        f32x4 bv[2][2];
#pragma unroll
        for (int bj = 0; bj < 2; ++bj)
#pragma unroll
            for (int n = 0; n < 2; ++n) bv[bj][n] = gate ? *(const f32x4*)(bgate + col0 + bj * HALF + 4 * n) : (f32x4){0.f, 0.f, 0.f, 0.f};
#pragma unroll
        for (int ai = 0; ai < 2; ++ai)
#pragma unroll
            for (int m = 0; m < 4; ++m) { bf16* rowp = base + (size_t)(row0 + ai * HALF + m * 16) * ldc + col0;
#pragma unroll
                for (int bj = 0; bj < 2; ++bj) { f32x4 v0 = acc[ai][bj][m][0] + bv[bj][0], v1 = acc[ai][bj][m][1] + bv[bj][1];
                    if (gate) {
#pragma unroll
                        for (int q = 0; q < 4; ++q) { v0[q] = sigmoidf_(v0[q]); v1[q] = sigmoidf_(v1[q]); } }
                    *(v4u*)(rowp + bj * HALF) = pack8(v0 * osc, v1 * osc); } }
    }
};
template <bool ADD> struct EpiGate {
    const bf16* G; int goff; const bf16* Tin; bf16* O;
    __device__ __forceinline__ void operator()(const Acc& acc, const Unit& u, int wr, int wc, int fr, int fq) const {
        const int row0 = u.pm * BM + wr * 64 + fr; const int col0 = u.pn * BM + wc * 32 + 8 * fq;
#pragma unroll
        for (int ai = 0; ai < 2; ++ai)
#pragma unroll
            for (int m = 0; m < 4; ++m) { const size_t row = (size_t)(row0 + ai * HALF + m * 16);
#pragma unroll
                for (int bj = 0; bj < 2; ++bj) { const int col = col0 + bj * HALF;
                    const v4u gw = *(const v4u*)(G + row * 2048 + goff + col); f32x4 g0, g1; unpack8(gw, g0, g1);
                    f32x4 v0 = acc[ai][bj][m][0] * g0, v1 = acc[ai][bj][m][1] * g1;
                    if (ADD) { const v4u tw = *(const v4u*)(Tin + row * DM + col); f32x4 t0, t1; unpack8(tw, t0, t1); v0 += t0; v1 += t1; }
                    *(v4u*)(O + row * DM + col) = pack8(v0, v1); } }
    }
};
struct EpiResid {
    const float* X; float* Z;
    __device__ __forceinline__ void operator()(const Acc& acc, const Unit& u, int wr, int wc, int fr, int fq) const {
        const int row0 = u.pm * BM + wr * 64 + fr; const int col0 = u.pn * BM + wc * 32 + 8 * fq;
#pragma unroll
        for (int ai = 0; ai < 2; ++ai)
#pragma unroll
            for (int m = 0; m < 4; ++m) { const size_t off = (size_t)(row0 + ai * HALF + m * 16) * DM + col0;
#pragma unroll
                for (int bj = 0; bj < 2; ++bj)
#pragma unroll
                    for (int n = 0; n < 2; ++n) { const f32x4 xv = *(const f32x4*)(X + off + bj * HALF + 4 * n); *(f32x4*)(Z + off + bj * HALF + 4 * n) = xv * ALPHA + acc[ai][bj][m][n]; } }
    }
};
struct EpiLogits {
    float* L;
    __device__ __forceinline__ void operator()(const Acc& acc, const Unit& u, int wr, int wc, int fr, int fq) const {
        const int row0 = u.pm * BM + wr * 64 + fr; const int col0 = wc * 32 + 8 * fq;
#pragma unroll
        for (int ai = 0; ai < 2; ++ai)
#pragma unroll
            for (int m = 0; m < 4; ++m) { const size_t off = (size_t)(row0 + ai * HALF + m * 16) * NE + col0;
#pragma unroll
                for (int bj = 0; bj < 2; ++bj)
#pragma unroll
                    for (int n = 0; n < 2; ++n) *(f32x4*)(L + off + bj * HALF + 4 * n) = acc[ai][bj][m][n]; }
    }
};
struct EpiSwiglu {
    bf16* HID;
    __device__ __forceinline__ void operator()(const Acc& acc, const Unit& u, int wr, int wc, int fr, int fq) const {
        const int row0 = u.pm * BM + wr * 64 + fr; const int col0 = u.pn * HALF + wc * 32 + 8 * fq;
#pragma unroll
        for (int ai = 0; ai < 2; ++ai)
#pragma unroll
            for (int m = 0; m < 4; ++m) { f32x4 h[2];
#pragma unroll
                for (int n = 0; n < 2; ++n) { const f32x4 g = acc[ai][0][m][n], up = acc[ai][1][m][n];
#pragma unroll
                    for (int q = 0; q < 4; ++q) h[n][q] = g[q] * sigmoidf_(g[q]) * up[q]; }
                *(v4u*)((char*)HID + (unsigned)((row0 + ai * HALF + m * 16) * ED + col0) * 2u) = pack8(h[0], h[1]); }
    }
};
struct EpiDownRouted {
    unsigned char* OS; const LAS int* lslot; const LAS float* lw;
    __device__ __forceinline__ void operator()(const Acc& acc, const Unit& u, int wr, int wc, int fr, int fq) const {
        const int col0 = u.pn * BM + wc * 64 + 16 * fq;
#pragma unroll
        for (int ai = 0; ai < 2; ++ai)
#pragma unroll
            for (int m = 0; m < 4; ++m) { const int lr = u.aux * 256 + wr * 64 + fr + ai * HALF + m * 16; const int slot = lslot[lr]; const float w = lw[lr] * OSCALE;
                if (slot >= 0) { v4u o;
#define F8PK(V0, V1) __builtin_amdgcn_cvt_pk_fp8_f32((V1)[2] * w, (V1)[3] * w, __builtin_amdgcn_cvt_pk_fp8_f32((V0)[0] * w, (V0)[1] * w, 0, false), true)
                    o.x = (unsigned)__builtin_amdgcn_cvt_pk_fp8_f32(acc[ai][0][m][0][2] * w, acc[ai][0][m][0][3] * w, __builtin_amdgcn_cvt_pk_fp8_f32(acc[ai][0][m][0][0] * w, acc[ai][0][m][0][1] * w, 0, false), true);
                    o.y = (unsigned)__builtin_amdgcn_cvt_pk_fp8_f32(acc[ai][0][m][1][2] * w, acc[ai][0][m][1][3] * w, __builtin_amdgcn_cvt_pk_fp8_f32(acc[ai][0][m][1][0] * w, acc[ai][0][m][1][1] * w, 0, false), true);
                    o.z = (unsigned)__builtin_amdgcn_cvt_pk_fp8_f32(acc[ai][1][m][0][2] * w, acc[ai][1][m][0][3] * w, __builtin_amdgcn_cvt_pk_fp8_f32(acc[ai][1][m][0][0] * w, acc[ai][1][m][0][1] * w, 0, false), true);
                    o.w = (unsigned)__builtin_amdgcn_cvt_pk_fp8_f32(acc[ai][1][m][1][2] * w, acc[ai][1][m][1][3] * w, __builtin_amdgcn_cvt_pk_fp8_f32(acc[ai][1][m][1][0] * w, acc[ai][1][m][1][1] * w, 0, false), true);
#undef F8PK
                    *(v4u*)(OS + (unsigned)(slot * DM + col0)) = o; } }
    }
};
struct EpiDownShared {
    bf16* YS; int shared_row0;
    __device__ __forceinline__ void operator()(const Acc& acc, const Unit& u, int wr, int wc, int fr, int fq) const {
        const int row0 = u.pm * BM + wr * 64 + fr - shared_row0; const int col0 = u.pn * BM + wc * 64 + 16 * fq;
#pragma unroll
        for (int ai = 0; ai < 2; ++ai)
#pragma unroll
            for (int m = 0; m < 4; ++m) { const unsigned ob = (unsigned)((row0 + ai * HALF + m * 16) * DM + col0) * 2u;
#pragma unroll
                for (int bj = 0; bj < 2; ++bj) *(v4u*)((char*)YS + ob + bj * 16) = pack8(acc[ai][bj][m][0], acc[ai][bj][m][1]); }
    }
};
}

namespace att {
constexpr int NW = 8, QBLK = 32, KVBLK = 64, PITCH = 512, QROWS = 128;
constexpr float THR2 = 8.f * 1.4426950408889634f;
constexpr int SHM_V = KVBLK * 128 * 2, SHM_K = KVBLK * 128 * 2;
constexpr int NSLOT = 4, L_K = 0, L_V = NSLOT * SHM_K, L_WS = LT_ATT, L_TAB = L_WS + NW * 64 * 4, L_LAM = L_TAB + NH * 452 * 4, L_END = L_LAM + 64;
constexpr int L_XCH = 0, L_STG = 65536;
static_assert(L_STG + 32768 <= 131072 && L_V + NSLOT * SHM_V <= 131072 && L_END <= LDS_BYTES, "attention LDS map");
#define SBAR() __builtin_amdgcn_sched_barrier(0)
#define KSWZ(row, colB) ((row) * 256 + ((colB) ^ (((row) & 7) << 4)))
__device__ __forceinline__ int crow(int r, int hi) { return (r & 3) + 8 * (r >> 2) + 4 * hi; }
__device__ __forceinline__ int v_st(int k, int c) { const int kk = (k & ~0xC) | ((k & 4) << 1) | ((k & 8) >> 1); return ((kk >> 3) * 4 + (c >> 5)) * 512 + ((kk & 7) * 32 + (c & 31)) * 2; }
__device__ __forceinline__ int v_rd_base(int lane) { return ((lane & 3) << 3) | (((lane >> 2) & 3) << 6) | (((lane >> 4) & 1) << 5) | (((lane >> 5) & 1) << 8); }
constexpr int v_rd_off(int d0, int ks, int half) { return d0 * 512 + ks * 4096 + half * 2048; }

__device__ __forceinline__ void partialSM(f32x16& p0, f32x16& p1, float& m_reg, float& alpha, const bool first) {
    float pmax = p0[0];
#pragma unroll
    for (int r = 1; r < 16; ++r) pmax = fmaxf(pmax, p0[r]);
#pragma unroll
    for (int r = 0; r < 16; ++r) pmax = fmaxf(pmax, p1[r]);
    { auto rr = __builtin_amdgcn_permlane32_swap(__float_as_uint(pmax), __float_as_uint(pmax), false, false);
      pmax = fmaxf(__uint_as_float(rr[0]), __uint_as_float(rr[1])); }
    if (__builtin_expect(!first && __all(pmax <= THR2), 1)) { alpha = 1.f; }
    else { const float mn = first ? pmax : fmaxf(pmax, 0.f); alpha = first ? 1.f : __builtin_amdgcn_exp2f(-mn); m_reg += mn;
#pragma unroll
        for (int r = 0; r < 16; ++r) { p0[r] -= mn; p1[r] -= mn; } }
#pragma unroll
    for (int r = 0; r < 16; ++r) p0[r] = __builtin_amdgcn_exp2f(p0[r]);
}
__device__ __forceinline__ void finishSM(f32x16& p0, f32x16& p1, float alpha, float& l_reg, bf16x8& pa0, bf16x8& pa1, bf16x8& pa2, bf16x8& pa3) {
#pragma unroll
    for (int r = 0; r < 16; ++r) p1[r] = __builtin_amdgcn_exp2f(p1[r]);
    float ps = 0;
#pragma unroll
    for (int r = 0; r < 16; ++r) ps += p0[r];
#pragma unroll
    for (int r = 0; r < 16; ++r) ps += p1[r];
    { auto rr = __builtin_amdgcn_permlane32_swap(__float_as_uint(ps), __float_as_uint(ps), false, false);
      ps = __uint_as_float(rr[0]) + __uint_as_float(rr[1]); }
    l_reg = l_reg * alpha + ps;
#define PK4(P, BASE, OUT) do { unsigned a0 = cvt_pk_bf16(P[BASE + 0], P[BASE + 1]), a1 = cvt_pk_bf16(P[BASE + 2], P[BASE + 3]);   \
    unsigned b0 = cvt_pk_bf16(P[BASE + 4], P[BASE + 5]), b1 = cvt_pk_bf16(P[BASE + 6], P[BASE + 7]);                              \
    auto r0 = __builtin_amdgcn_permlane32_swap(a0, b0, false, false); auto r1 = __builtin_amdgcn_permlane32_swap(a1, b1, false, false); \
    v4u w = {r0[0], r1[0], r0[1], r1[1]}; OUT = *reinterpret_cast<bf16x8*>(&w); } while (0)
    PK4(p0, 0, pa0); PK4(p0, 8, pa1); PK4(p1, 0, pa2); PK4(p1, 8, pa3);
#undef PK4
}
__device__ __forceinline__ float fadd_s(float a, float b) { float r; asm("v_add_f32_e32 %0, %1, %2" : "=v"(r) : "v"(a), "v"(b)); return r; }
__device__ __forceinline__ void qkt(f32x16& p0, f32x16& p1, const LAS char* Ks, const bf16x8* qr, int r32, int hi, int kcb, float init) {
#pragma unroll
    for (int r = 0; r < 16; ++r) { p0[r] = init; p1[r] = init; }
#pragma unroll
    for (int d0 = 0; d0 < 4; ++d0) { const int cb = kcb + (d0 * 16 + hi * 8) * 2;
        const bf16x8 b0 = *(const LAS bf16x8*)(Ks + KSWZ(r32, cb));
        const bf16x8 b1 = *(const LAS bf16x8*)(Ks + KSWZ(32 + r32, cb));
        p0 = __builtin_amdgcn_mfma_f32_32x32x16_bf16(b0, qr[d0], p0, 0, 0, 0);
        p1 = __builtin_amdgcn_mfma_f32_32x32x16_bf16(b1, qr[d0], p1, 0, 0, 0); }
}
typedef short v4i16_t __attribute__((ext_vector_type(4)));
__device__ __forceinline__ s16x4 vtr(const LAS char* p) { return __builtin_bit_cast(s16x4, __builtin_amdgcn_ds_read_tr16_b64_v4i16((LAS v4i16_t*)p)); }
__device__ __forceinline__ void pv_d0(f32x16* o, const LAS char* vp, bf16x8 pa0, bf16x8 pa1, bf16x8 pa2, bf16x8 pa3) {
    s16x4 lo[4][4], hi[4][4];
#define PVRD(ks) do { _Pragma("unroll") for (int d0 = 0; d0 < 4; ++d0) { lo[ks][d0] = vtr(vp + v_rd_off(d0, ks, 0)); hi[ks][d0] = vtr(vp + v_rd_off(d0, ks, 1)); } } while (0)
#define PVMM(ks, PA) do { _Pragma("unroll") for (int d0 = 0; d0 < 4; ++d0) o[d0] = __builtin_amdgcn_mfma_f32_32x32x16_bf16(PA, \
        ((bf16x8){lo[ks][d0][0], lo[ks][d0][1], lo[ks][d0][2], lo[ks][d0][3], hi[ks][d0][0], hi[ks][d0][1], hi[ks][d0][2], hi[ks][d0][3]}), o[d0], 0, 0, 0); } while (0)
    PVRD(0); PVRD(1); SBAR();
    PVMM(0, pa0); PVRD(2); SBAR();
    PVMM(1, pa1); PVRD(3); SBAR();
    PVMM(2, pa2); PVMM(3, pa3);
#undef PVRD
#undef PVMM
}

__device__ __forceinline__ void attn_pass(const bf16* __restrict__ Qw, const bf16* __restrict__ Kh, const bf16* __restrict__ Vh, int q0, LAS char* lds, const LAS float* tab,
                                          f32x16 (&o)[4], float& l_out, const int wave0) {
    const int tid = opaque_tid(wave0), wid = __builtin_amdgcn_readfirstlane(tid >> 6), lane = tid & 63, r32 = lane & 31, hi = lane >> 5;
    LAS float* ws = (LAS float*)(lds + L_WS) + wid * 64; LAS float* al_l = ws + 32;
    float m_reg = 0.f, l_reg = 0.f; bf16x8 qr[4];
#pragma unroll
    for (int d = 0; d < 4; ++d) o[d] = (f32x16){0.f, 0.f, 0.f, 0.f, 0.f, 0.f, 0.f, 0.f, 0.f, 0.f, 0.f, 0.f, 0.f, 0.f, 0.f, 0.f};
#pragma unroll
    for (int d0 = 0; d0 < 4; ++d0) qr[d0] = *reinterpret_cast<const bf16x8*>(Qw + d0 * 16);
    unsigned kgo[2], vgo[2];
#pragma unroll
    for (int i = 0; i < 2; ++i) { const int a = (wid * 2 + i) * 1024 + 16 * lane;
        { const int row = a >> 8, cb = (a & 255) ^ ((row & 7) << 4); kgo[i] = (unsigned)(row * PITCH * 2 + cb); }
        { const int sub = a >> 9, w = (a & 511) >> 1, kk = (sub >> 2) * 8 + (w >> 5), k = (kk & ~0xC) | ((kk & 4) << 1) | ((kk & 8) >> 1), c = (sub & 3) * 32 + (w & 31); vgo[i] = (unsigned)(k * PITCH * 2 + c * 2); } }
    const unsigned pw = (unsigned)wid * 2048u;
#define DMA(t, s) do { const char* kt_ = (const char*)(Kh + (size_t)(t) * KVBLK * PITCH); const char* vt_ = (const char*)(Vh + (size_t)(t) * KVBLK * PITCH); \
    _Pragma("unroll") for (int _i = 0; _i < 2; ++_i) { unsigned ko_ = kgo[_i], vo_ = vgo[_i]; asm volatile("" : "+v"(ko_), "+v"(vo_)); \
        __builtin_amdgcn_global_load_lds((const unsigned*)(kt_ + ko_), (LAS unsigned*)(lds + L_K + (s) * SHM_K + pw + _i * 1024), 16, 0, 0); \
        __builtin_amdgcn_global_load_lds((const unsigned*)(vt_ + vo_), (LAS unsigned*)(lds + L_V + (s) * SHM_V + pw + _i * 1024), 16, 0, 0); } } while (0)
    const LAS char* vb0 = lds + L_V + v_rd_base(lane);
    const int kcb = (wid >> 2) * 128;
    const int qwlo = q0 + (wid & 3) * QBLK;
    const int qpos = qwlo + r32;
#define RESC(a) do { if (__any((a) < 1.f)) { if (hi == 0) al_l[r32] = (a); asm volatile("s_waitcnt lgkmcnt(0)" ::: "memory"); \
    _Pragma("unroll") for (int d = 0; d < 4; ++d) _Pragma("unroll") for (int r = 0; r < 16; ++r) o[d][r] *= al_l[crow(r, hi)]; } } while (0)
#define BFAR(k0) (((k0) + 63 - qwlo <= -128) || ((k0) - (qwlo + 31) >= 128))
#define BINIT(k0) ((((k0) + 63 - qwlo <= -128) ? tab[224 - 128] : (((k0) - (qwlo + 31) >= 128) ? tab[224 + 128] : 0.f)) - m_reg)
#define BNEAR(P0, P1, k0) do { if (!BFAR(k0)) { const LAS float* tb_ = tab + ((k0) - qpos + 224 + 4 * hi); \
    _Pragma("unroll") for (int r4 = 0; r4 < 4; ++r4) { \
        _Pragma("unroll") for (int rr = 0; rr < 4; ++rr) { P0[r4 * 4 + rr] += tb_[8 * r4 + rr]; P1[r4 * 4 + rr] += tb_[8 * r4 + rr + 32]; } \
        asm volatile("" ::: "memory"); } } } while (0)
#define WAITBAR(n) asm volatile("s_waitcnt vmcnt(" #n ") lgkmcnt(0)\n\ts_barrier" ::: "memory")
#define KFR(d0, half) (*(const LAS bf16x8*)(ks_ + KSWZ((half) * 32 + r32, kcb + ((d0) * 16 + hi * 8) * 2)))
#define PK4(P, BASE, OUT) do { unsigned a0 = cvt_pk_bf16(P[BASE + 0], P[BASE + 1]), a1 = cvt_pk_bf16(P[BASE + 2], P[BASE + 3]);   \
    unsigned b0 = cvt_pk_bf16(P[BASE + 4], P[BASE + 5]), b1 = cvt_pk_bf16(P[BASE + 6], P[BASE + 7]);                              \
    auto r0 = __builtin_amdgcn_permlane32_swap(a0, b0, false, false); auto r1 = __builtin_amdgcn_permlane32_swap(a1, b1, false, false); \
    v4u w = {r0[0], r1[0], r0[1], r1[1]}; OUT = *reinterpret_cast<bf16x8*>(&w); } while (0)
#define QKFS(P0, P1, Q0, Q1, alQ, Ks, INIT) do { const LAS char* ks_ = (Ks); const float in_ = (INIT); float ps_ = 0.f; \
    const bf16x8 ka0 = KFR(0, 0), kb0 = KFR(0, 1), ka1 = KFR(1, 0), kb1 = KFR(1, 1); \
    _Pragma("unroll") for (int r = 0; r < 16; ++r) { P0[r] = in_; P1[r] = in_; } \
    SBAR(); \
    P0 = __builtin_amdgcn_mfma_f32_32x32x16_bf16(ka0, qr[0], P0, 0, 0, 0); P1 = __builtin_amdgcn_mfma_f32_32x32x16_bf16(kb0, qr[0], P1, 0, 0, 0); \
    const bf16x8 ka2 = KFR(2, 0), kb2 = KFR(2, 1); \
    _Pragma("unroll") for (int r = 0; r < 8; ++r) { Q1[r] = __builtin_amdgcn_exp2f(Q1[r]); ps_ = fadd_s(ps_, Q0[r]); } \
    SBAR(); \
    P0 = __builtin_amdgcn_mfma_f32_32x32x16_bf16(ka1, qr[1], P0, 0, 0, 0); P1 = __builtin_amdgcn_mfma_f32_32x32x16_bf16(kb1, qr[1], P1, 0, 0, 0); \
    const bf16x8 ka3 = KFR(3, 0), kb3 = KFR(3, 1); \
    _Pragma("unroll") for (int r = 8; r < 16; ++r) { Q1[r] = __builtin_amdgcn_exp2f(Q1[r]); ps_ = fadd_s(ps_, Q0[r]); } \
    SBAR(); \
    P0 = __builtin_amdgcn_mfma_f32_32x32x16_bf16(ka2, qr[2], P0, 0, 0, 0); P1 = __builtin_amdgcn_mfma_f32_32x32x16_bf16(kb2, qr[2], P1, 0, 0, 0); \
    float ps2_ = Q1[0]; _Pragma("unroll") for (int r = 1; r < 16; ++r) ps2_ = fadd_s(ps2_, Q1[r]); ps_ = fadd_s(ps_, ps2_); \
    { auto rr = __builtin_amdgcn_permlane32_swap(__float_as_uint(ps_), __float_as_uint(ps_), false, false); ps_ = __uint_as_float(rr[0]) + __uint_as_float(rr[1]); } \
    l_reg = l_reg * (alQ) + ps_; PK4(Q0, 0, pa0); \
    SBAR(); \
    P0 = __builtin_amdgcn_mfma_f32_32x32x16_bf16(ka3, qr[3], P0, 0, 0, 0); P1 = __builtin_amdgcn_mfma_f32_32x32x16_bf16(kb3, qr[3], P1, 0, 0, 0); \
    PK4(Q0, 8, pa1); PK4(Q1, 0, pa2); PK4(Q1, 8, pa3); \
    SBAR(); } while (0)
#define SLOTK(t) (lds + L_K + ((t) & 3) * SHM_K)
#define SLOTV(t) (vb0 + ((t) & 3) * SHM_V)
#define STEP_A(P0, P1, alP, Q0, Q1, alQ, t, more) do { \
    SBAR(); if (more) DMA((t) + 1, ((t) + 1) & 3); SBAR(); \
    QKFS(P0, P1, Q0, Q1, alQ, SLOTK(t), BINIT((t) * KVBLK)); BNEAR(P0, P1, (t) * KVBLK); SBAR(); \
    pv_d0(o, SLOTV((t) - 1), pa0, pa1, pa2, pa3); partialSM(P0, P1, m_reg, alP, false); \
    WAITBAR(0); RESC(alP); } while (0)
#define STEP_B(P0, P1, Q0, Q1, alQ, t, more) do { \
    SBAR(); if (more) DMA((t) + 1, ((t) + 1) & 3); SBAR(); \
    pv_d0(o, SLOTV((t) - 2), pa0, pa1, pa2, pa3); partialSM(Q0, Q1, m_reg, alQ, false); RESC(alQ); SBAR(); \
    QKFS(P0, P1, Q0, Q1, alQ, SLOTK(t), BINIT((t) * KVBLK)); BNEAR(P0, P1, (t) * KVBLK); \
    WAITBAR(0); } while (0)
    f32x16 pA0, pA1, pB0, pB1; float alA = 1.f, alB = 1.f; bf16x8 pa0, pa1, pa2, pa3; constexpr int NT = SEQ / KVBLK;
    DMA(0, 0); DMA(1, 1);
    WAITBAR(4);
    if (wid < 4) {
        qkt(pA0, pA1, SLOTK(0), qr, r32, hi, kcb, BINIT(0)); BNEAR(pA0, pA1, 0); partialSM(pA0, pA1, m_reg, alA, true);
        WAITBAR(0);
        STEP_A(pB0, pB1, alB, pA0, pA1, alA, 1, true);
        for (int t = 2; t + 1 < NT; t += 2) {
            STEP_A(pA0, pA1, alA, pB0, pB1, alB, t, true);
            STEP_A(pB0, pB1, alB, pA0, pA1, alA, t + 1, (t + 2 < NT));
        }
        finishSM(pB0, pB1, alB, l_reg, pa0, pa1, pa2, pa3); SBAR();
        pv_d0(o, SLOTV(NT - 1), pa0, pa1, pa2, pa3);
    } else {
        qkt(pA0, pA1, SLOTK(0), qr, r32, hi, kcb, BINIT(0)); BNEAR(pA0, pA1, 0);
        WAITBAR(0);
        SBAR(); DMA(2, 2); SBAR();
        partialSM(pA0, pA1, m_reg, alA, true); SBAR();
        QKFS(pB0, pB1, pA0, pA1, alA, SLOTK(1), BINIT(KVBLK)); BNEAR(pB0, pB1, KVBLK);
        WAITBAR(0);
        for (int t = 2; t + 1 < NT; t += 2) {
            STEP_B(pA0, pA1, pB0, pB1, alB, t, true);
            STEP_B(pB0, pB1, pA0, pA1, alA, t + 1, (t + 2 < NT));
        }
        pv_d0(o, SLOTV(NT - 2), pa0, pa1, pa2, pa3); partialSM(pB0, pB1, m_reg, alB, false); RESC(alB);
        finishSM(pB0, pB1, alB, l_reg, pa0, pa1, pa2, pa3); SBAR();
        pv_d0(o, SLOTV(NT - 1), pa0, pa1, pa2, pa3);
    }
    l_out = l_reg;
    __syncthreads();
#undef SLOTK
#undef SLOTV
#undef STEP_A
#undef STEP_B
#undef DMA
#undef RESC
#undef BINIT
#undef BFAR
#undef BNEAR
#undef WAITBAR
#undef QKFS
#undef KFR
#undef PK4
}
}

#define XB_TMO      128
#define XB_XCNT(j)  (256  + 64 * (j))
#define XB_XSUB(j)  (1280 + 64 * (j))
#define XB_XGEN(j)  (2304 + 64 * (j))
#define XB_TOP      3328
#define XB_TOPGEN   3392
#define XCD_BAR_WORDS 3456
#define XB_SPIN_CAP (1u << 18)
__device__ __forceinline__ unsigned xb_ld(unsigned* p)              { return __hip_atomic_load(p, __ATOMIC_RELAXED, __HIP_MEMORY_SCOPE_AGENT); }
__device__ __forceinline__ unsigned xb_add(unsigned* p, unsigned v) { return __hip_atomic_fetch_add(p, v, __ATOMIC_RELAXED, __HIP_MEMORY_SCOPE_AGENT); }
__device__ __forceinline__ unsigned xb_xcc_id() { return (unsigned)__builtin_amdgcn_s_getreg((3 << 11) | 20) & 0xFu; }
#define XB_SPIN(cond, bar) do { unsigned _sp = 0; while (cond) { __builtin_amdgcn_s_sleep(1); \
    if ((++_sp & 255u) == 0u) { if (xb_ld(&(bar)[XB_TMO])) break; if (_sp > XB_SPIN_CAP) { atomicAdd(&(bar)[XB_TMO], 1u); break; } } } } while (0)
struct XcdBarrier { unsigned* bar; unsigned x; volatile LAS unsigned* st; };
__device__ __forceinline__ XcdBarrier xcd_barrier_post(unsigned* bar, volatile LAS unsigned* st) {
    XcdBarrier b; b.bar = bar; b.x = xb_xcc_id(); b.st = st;
    if (threadIdx.x == 0) (void)xb_add(&bar[XB_XCNT(b.x)], 1u);
    return b;
}
__device__ __forceinline__ void xcd_barrier_complete(unsigned* bar, unsigned x, unsigned& nloc, unsigned& nx) {
    const unsigned G = gridDim.x * gridDim.y * gridDim.z;
    unsigned sum, cnt, mine, sp = 0u;
    for (;;) {
        sum = 0u; cnt = 0u; mine = 0u;
#pragma unroll
        for (unsigned j = 0; j < 16; ++j) { const unsigned c = xb_ld(&bar[XB_XCNT(j)]); sum += c; cnt += (c > 0u) ? 1u : 0u; mine = (j == x) ? c : mine; }
        if (sum == G) break;
        __builtin_amdgcn_s_sleep(1);
        if ((++sp & 255u) == 0u) { if (xb_ld(&bar[XB_TMO])) break; if (sp > XB_SPIN_CAP) { atomicAdd(&bar[XB_TMO], 1u); break; } }
    }
    nloc = mine > 0u ? mine : 1u; nx = cnt > 0u ? cnt : 1u;
}
__device__ __forceinline__ void xcd_barrier(const XcdBarrier& b) {
    asm volatile("s_waitcnt vmcnt(0)" ::: "memory");
    __syncthreads();
    if (threadIdx.x == 0) {
        unsigned* bar = b.bar;
        __builtin_amdgcn_s_waitcnt(0);
        unsigned nloc = b.st[0], nx = b.st[1];
        if (nloc == 0u) { xcd_barrier_complete(bar, b.x, nloc, nx); b.st[0] = nloc; b.st[1] = nx; }
        const unsigned old = xb_add(&bar[XB_XSUB(b.x)], 1u);
        const unsigned gen = old / nloc;
        if (old + 1u == (gen + 1u) * nloc) {
            __builtin_amdgcn_fence(__ATOMIC_RELEASE, "agent");
            asm volatile("s_waitcnt vmcnt(0)" ::: "memory");
            const unsigned og = xb_add(&bar[XB_TOP], 1u);
            const unsigned tg = og / nx;
            if (og + 1u == (tg + 1u) * nx) xb_add(&bar[XB_TOPGEN], 1u);
            else XB_SPIN(xb_ld(&bar[XB_TOPGEN]) == tg, bar);
            __builtin_amdgcn_fence(__ATOMIC_ACQUIRE, "agent");
            xb_add(&bar[XB_XGEN(b.x)], 1u);
            asm volatile("s_waitcnt vmcnt(0)" ::: "memory");
        } else {
            XB_SPIN(xb_ld(&bar[XB_XGEN(b.x)]) == gen, bar);
            __builtin_amdgcn_fence(__ATOMIC_ACQUIRE, "agent");
            asm volatile("s_waitcnt vmcnt(0)" ::: "memory");
        }
    }
    __syncthreads();
}

struct Args { const float* in[26]; float* out; unsigned char* ws; int ph_lo, ph_hi; };
enum { I_X = 0, I_RELB, I_WIN, I_BGATE, I_WPG, I_PSC, I_WBP, I_LQ1, I_LK1, I_LQ2, I_LK2, I_SUBG, I_WBA, I_WOUT, I_LN1G, I_LN1B, I_WR, I_RB, I_WEG, I_WEU, I_WED, I_WSG, I_WSU, I_WSD, I_LN2G, I_LN2B };

struct TrItem { const float* src; bf16* dst; int ldw, ldt, q0; };
__device__ __forceinline__ void tr_load(const TrItem& t, f32x4 (&v)[8], int lane) {
    const int lr = lane >> 3, lc = (lane & 7) * 4;
#pragma unroll
    for (int j = 0; j < 8; ++j) v[j] = *(const f32x4*)(t.src + (size_t)(lr + 8 * j) * t.ldw + lc);
}
__device__ __forceinline__ void tr_finish(const TrItem& t, const f32x4 (&v)[8], LAS float* scr, int lane) {
    const int lr = lane >> 3, lc = (lane & 7) * 4;
#pragma unroll
    for (int j = 0; j < 8; ++j) { LAS float* d = scr + (lr + 8 * j) * 33 + lc; d[0] = v[j].x; d[1] = v[j].y; d[2] = v[j].z; d[3] = v[j].w; }
    LDS_WAIT(); asm volatile("" ::: "memory");
    const int c = lane & 7;
#pragma unroll
    for (int j = 0; j < 4; ++j) { const int n = (lane >> 3) + 8 * j; const LAS float* s = scr + (8 * c) * 33 + n;
        v4u o; o.x = cvt_pk_bf16(s[0 * 33], s[1 * 33]); o.y = cvt_pk_bf16(s[2 * 33], s[3 * 33]); o.z = cvt_pk_bf16(s[4 * 33], s[5 * 33]); o.w = cvt_pk_bf16(s[6 * 33], s[7 * 33]);
        const int r_ = t.q0 + n; const int drow = t.q0 < 0 ? n : 128 * ((r_ >> 3) & 1) + 8 * (r_ >> 4) + (r_ & 7);
        *(v4u*)(t.dst + (size_t)drow * t.ldt + 8 * c) = o; }
    LDS_WAIT(); asm volatile("" ::: "memory");
}

__device__ __forceinline__ float readlane_f(float v, int l) { return __uint_as_float((unsigned)__builtin_amdgcn_readlane((int)__float_as_uint(v), l)); }
template <int CTRL> __device__ __forceinline__ float dpp_f(float v) { return __uint_as_float((unsigned)__builtin_amdgcn_update_dpp((int)__float_as_uint(v), (int)__float_as_uint(v), CTRL, 0xf, 0xf, false)); }
__device__ __forceinline__ float row_max16(float v) {
    v = fmaxf(v, dpp_f<0xB1>(v)); v = fmaxf(v, dpp_f<0x4E>(v)); v = fmaxf(v, dpp_f<0x141>(v)); v = fmaxf(v, dpp_f<0x140>(v)); return v;
}
__device__ __forceinline__ float wave_max_f(float v) {
    v = row_max16(v);
    const float r0 = readlane_f(v, 0), r1 = readlane_f(v, 16), r2 = readlane_f(v, 32), r3 = readlane_f(v, 48);
    return fmaxf(fmaxf(r0, r1), fmaxf(r2, r3));
}
template <int W> __device__ __forceinline__ void pool_item(const bf16* base, int sp, bf16* dst) {
    v4u v[W]; float a[8];
#pragma unroll
    for (int i = 0; i < W; ++i) { int p = sp - W / 2 + i; p = p < 0 ? 0 : (p > SEQ - 1 ? SEQ - 1 : p); v[i] = *(const v4u*)(base + (size_t)p * PW); }
#pragma unroll
    for (int q = 0; q < 8; ++q) a[q] = 0.f;
#pragma unroll
    for (int i = 0; i < W; ++i) { const int p = sp - W / 2 + i; const float m = (p >= 0 && p < SEQ) ? 1.f : 0.f;
        a[0] += m * bf_lo(v[i].x); a[1] += m * bf_hi(v[i].x); a[2] += m * bf_lo(v[i].y); a[3] += m * bf_hi(v[i].y); a[4] += m * bf_lo(v[i].z); a[5] += m * bf_hi(v[i].z); a[6] += m * bf_lo(v[i].w); a[7] += m * bf_hi(v[i].w); }
    int lo_ = sp - W / 2, hi_ = sp + W / 2; lo_ = lo_ < 0 ? 0 : lo_; hi_ = hi_ > SEQ ? SEQ : hi_;
    const float inv = 1.0f / (float)(hi_ - lo_); const v4u sv = v[W / 2];
    const f32x4 r0 = {a[0] * inv - bf_lo(sv.x), a[1] * inv - bf_hi(sv.x), a[2] * inv - bf_lo(sv.y), a[3] * inv - bf_hi(sv.y)};
    const f32x4 r1 = {a[4] * inv - bf_lo(sv.z), a[5] * inv - bf_hi(sv.z), a[6] * inv - bf_lo(sv.w), a[7] * inv - bf_hi(sv.w)};
    *(v4u*)dst = pg8::pack8(r0, r1);
}

__device__ __forceinline__ void build_tables(LAS unsigned char* lds, const int* CNT, int G, int bx, int tid) {
    LAS int* tot = (LAS int*)(lds + RING_OFF); LAS int* before = tot + 256; LAS int* tstart = tot + 512;
    LAS unsigned short* tile_e = (LAS unsigned short*)(lds + LT_TILE_E); LAS int* ntr_p = (LAS int*)(lds + LT_NTR);
    if (tid < NE) { int bsum = 0, tsum = 0;
#pragma unroll 16
        for (int w = 0; w < G; ++w) { const int v = CNT[w * NE + tid]; tsum += v; bsum += (w < bx) ? v : 0; }
        tot[tid] = tsum; before[tid] = bsum; tstart[tid] = (tsum + 255) >> 8; }
    __syncthreads();
    { LAS int* scan2 = tot + 1280; LAS int* src = tstart; LAS int* dst = scan2;
      for (int off = 1; off < NE; off <<= 1) { if (tid < NE) dst[tid] = src[tid] + (tid >= off ? src[tid - off] : 0); __syncthreads(); LAS int* tmp = src; src = dst; dst = tmp; }
      int incl = 0, mine = 0; if (tid < NE) { incl = src[tid]; mine = (tot[tid] + 255) >> 8; }
      __syncthreads();
      if (tid < NE) { tstart[tid] = incl - mine; if (tid == NE - 1) ntr_p[0] = incl; } }
    __syncthreads();
    const int NTr = ntr_p[0];
    if (tid < NE) { const int ts = tstart[tid], nt_ = (tot[tid] + 255) >> 8; for (int i = 0; i < nt_; ++i) tile_e[ts + i] = (unsigned short)tid; }
    for (int i = tid; i < M / 256; i += NWAVES * 64) tile_e[NTr + i] = (unsigned short)NE;
    __syncthreads();
}

__global__ void __launch_bounds__(NWAVES * 64, 2) fwd_kernel(Args args) {
    extern __shared__ __attribute__((aligned(16))) unsigned char lds_raw[];
    LAS unsigned char* lds = (LAS unsigned char*)lds_raw;
    volatile LAS unsigned* MISC = (volatile LAS unsigned*)(lds + MISC_OFF);
    const int wave0 = __builtin_amdgcn_readfirstlane(threadIdx.x >> 6);
    const int G = gridDim.x; const int bx = blockIdx.x; const int vcu = (G % 8 == 0) ? (bx % 8) * (G / 8) + bx / 8 : bx;
    unsigned char* ws = args.ws;
    gu32* ctl = (gu32*)(ws + WS_CTL);
    for (int u = threadIdx.x; u < 512 / 4; u += NWAVES * 64) ((LAS unsigned*)(lds + LDSCTL_OFF))[u] = 0u;
    __syncthreads();
    XcdBarrier bar = xcd_barrier_post((unsigned*)(ctl + CW_BAR), MISC + 8);
    const int lo = args.ph_lo, hi = args.ph_hi;
#ifndef PH_MASK
#define PH_MASK 0xFFF
#endif
#define IN(k) (((PH_MASK >> (k)) & 1) && lo <= (k) && (k) < hi)
#define SEAM(k) do { if (IN(k) && IN((k) + 1)) xcd_barrier(bar); } while (0)
    bf16* WinT = (bf16*)(ws + WS_WINT); bf16* WpT = (bf16*)(ws + WS_WPT); bf16* WaT = (bf16*)(ws + WS_WAT); bf16* WoT = (bf16*)(ws + WS_WOT); bf16* WrT = (bf16*)(ws + WS_WRT);
    bf16* WguT = (bf16*)(ws + WS_WGUT); bf16* WdT = (bf16*)(ws + WS_WDT);
    bf16* XB = (bf16*)(ws + WS_XB); bf16* Ub = (bf16*)(ws + WS_U); bf16* Qb = (bf16*)(ws + WS_Q); bf16* Kb = (bf16*)(ws + WS_K); bf16* Vb = (bf16*)(ws + WS_V); bf16* Gb = (bf16*)(ws + WS_G);
    bf16* PL = (bf16*)(ws + WS_PL); bf16* ON = (bf16*)(ws + WS_ON); float* STASH = (float*)(ws + WS_STASH);
    bf16* Tb = (bf16*)(ws + WS_T); bf16* MG = (bf16*)(ws + WS_MG); float* Z = (float*)(ws + WS_Z);
    bf16* H1B = (bf16*)(ws + WS_H1B); bf16* YSB = (bf16*)(ws + WS_YSB); float* LOG = (float*)(ws + WS_LOG);
    int* IDX = (int*)(ws + WS_IDX); float* TKW = (float*)(ws + WS_TKW); int* CNT = (int*)(ws + WS_CNT);
    int* RTOK = (int*)(ws + WS_RTOK); float* RW = (float*)(ws + WS_RW); int* RSLOT = (int*)(ws + WS_RSLOT);
    bf16* HID = (bf16*)(ws + WS_HID); unsigned char* OS = (unsigned char*)(ws + WS_OS);
    const int NGW = G * NWAVES, NGT = G * NWAVES * 64;
#define PHASE_IDS const int tid = opaque_tid(wave0), lane = tid & 63, wave = __builtin_amdgcn_readfirstlane(tid >> 6), gw = vcu * NWAVES + wave, gt = vcu * (NWAVES * 64) + tid; (void)lane; (void)gw; (void)gt;

    if (IN(0)) { PHASE_IDS
        LAS float* scr = (LAS float*)(lds + RING_OFF + wave * 16384);
        constexpr int I0 = 2048, I1 = I0 + 512, I2 = I1 + 128, I3 = I2 + 257 * 128, I4 = I3 + 257 * 128, I5 = I4 + 257 * 128;
        auto decode = [&](int it) -> TrItem {
            if (it < I0) { const int kb = it / 128, nb = it % 128; return TrItem{args.in[I_WIN] + (size_t)(64 * kb) * INW + 32 * nb, WinT + (size_t)(32 * nb) * DM + 64 * kb, INW, DM, -1}; }
            if (it < I1) { const int r = it - I0, kb = r / 32, nb = r % 32; return TrItem{args.in[I_WOUT] + (size_t)(64 * kb) * DM + 32 * nb, WoT + (size_t)(32 * nb) * DM + 64 * kb, DM, DM, -1}; }
            if (it < I2) { const int r = it - I1, kb = r / 8, nb = r % 8; return TrItem{args.in[I_WR] + (size_t)(64 * kb) * NE + 32 * nb, WrT + (size_t)(32 * nb) * DM + 64 * kb, NE, DM, -1}; }
            if (it < I4) { const bool up = it >= I3; const int r = it - (up ? I3 : I2), e = r / 128, q = r % 128, kb = q / 8, nb = q % 8, n0 = 32 * nb;
                const float* W = e < NE ? args.in[up ? I_WEU : I_WEG] + (size_t)e * DM * ED : args.in[up ? I_WSU : I_WSG];
                const int drow0 = e * 512 + 256 * (n0 >> 7) + (n0 & 127) + (up ? 128 : 0);
                return TrItem{W + (size_t)(64 * kb) * ED + n0, WguT + (size_t)drow0 * DM + 64 * kb, ED, DM, -1}; }
            { const int r = it - I4, e = r / 128, q = r % 128, kb = q / 32, nb = q % 32;
              const float* W = e < NE ? args.in[I_WED] + (size_t)e * ED * DM : args.in[I_WSD];
              const int n0 = 32 * nb, grp = (n0 >> 8) * 256 + ((n0 & 255) >> 6) * 32;
              return TrItem{W + (size_t)(64 * kb) * DM + n0, WdT + (size_t)(e * DM + grp) * ED + 64 * kb, DM, ED, n0 & 63}; }
        };
        { int it = gw; f32x4 va[8], vb[8]; TrItem ta{}, tb{};
          if (it < I5) { ta = decode(it); tr_load(ta, va, lane); }
          while (it < I5) {
              const int itn = it + NGW; if (itn < I5) { tb = decode(itn); tr_load(tb, vb, lane); }
              tr_finish(ta, va, scr, lane);
              it = itn + NGW; if (itn < I5) { if (it < I5) { ta = decode(it); tr_load(ta, va, lane); } tr_finish(tb, vb, scr, lane); }
          } }
        { const float* x = args.in[I_X];
          constexpr size_t NCH = (size_t)M * DM / 8;
          for (size_t i = gt; i < NCH; i += (size_t)NGT * 4) { f32x4 a[4], b[4];
#pragma unroll
              for (int q = 0; q < 4; ++q) { const size_t c = i + (size_t)q * NGT; if (c < NCH) { a[q] = *(const f32x4*)(x + c * 8); b[q] = *(const f32x4*)(x + c * 8 + 4); } }
#pragma unroll
              for (int q = 0; q < 4; ++q) { const size_t c = i + (size_t)q * NGT; if (c < NCH) *(v4u*)(XB + c * 8) = pg8::pack8(a[q], b[q]); } } }
        { const float* wg = args.in[I_WPG]; const float* ps = args.in[I_PSC]; const float* wbp = args.in[I_WBP]; const float* wba = args.in[I_WBA]; const float* sg = args.in[I_SUBG];
          for (int i = gt; i < (PW / 8) * DM; i += NGT) { const int kk0 = (i / DM) * 8, n = i % DM, g = kk0 >> 7;
              float acc[8];
#pragma unroll
              for (int q = 0; q < 8; ++q) acc[q] = 0.f;
#pragma unroll 16
              for (int d = 0; d < 128; ++d) { const float b = wbp[(size_t)(g * 128 + d) * DM + n] * ps[g * 128 + d];
#pragma unroll
                  for (int q = 0; q < 8; ++q) acc[q] += wg[(kk0 + q) * 128 + d] * b; }
              *(v4u*)(WpT + (size_t)n * PW + kk0) = pg8::pack8((f32x4){acc[0], acc[1], acc[2], acc[3]}, (f32x4){acc[4], acc[5], acc[6], acc[7]}); }
          for (int i = gt; i < DM * AW; i += NGT) { const int k = i / DM, n = i % DM; const float s = wba[i] * sg[k & 127] * (1.0f - LAM_INIT);
              WaT[(size_t)n * AW + k] = (bf16)(cvt_pk_bf16(s, 0.f) & 0xffffu); } }
    }
    SEAM(0);

    if (IN(1)) { PHASE_IDS
        pg8::DenseOrder S; S.init(XB, WinT, M, INW, DM, G, bx, DUP(1));
        pg8::EpiInProj E{Ub, Qb, Kb, Vb, Gb, args.in[I_BGATE]};
        pg8::gemm_phase<pg8::EpiInProj, pg8::DenseOrder, false>(lds + RING_OFF, DM, S, E, nullptr, wave0);
    }
    SEAM(1);

    if (IN(2)) { PHASE_IDS
        { const int sub = lane >> 4, ch = lane & 15;
          for (int it = gw; it < M; it += NGW) { const int g = it & 3, tq = it >> 2, t = tq * 4 + sub, sp = t & (SEQ - 1);
              const bf16* base = Ub + (size_t)(t - sp) * PW + g * 128 + ch * 8; bf16* dst = PL + (size_t)t * PW + g * 128 + ch * 8;
              if (g == 0) pool_item<2>(base, sp, dst); else if (g == 1) pool_item<4>(base, sp, dst); else if (g == 2) pool_item<8>(base, sp, dst); else pool_item<16>(base, sp, dst); } }
        LAS char* al = (LAS char*)(lds + RING_OFF);
        LAS float* tab = (LAS float*)(al + att::L_TAB); LAS float* lamp = (LAS float*)(al + att::L_LAM);
        { const float* tbl = args.in[I_RELB];
          for (int i = tid; i < NH * 449; i += NWAVES * 64) { const int h = i / 449, rel = i % 449 - 224; const int n = rel < 0 ? -rel : rel; int bk = rel > 0 ? 16 : 0;
              if (n < 8) bk += n; else { int lg = 31 - __builtin_clz((unsigned)(n * n)) - 6 + 8; bk += lg > 15 ? 15 : lg; }
              tab[h * 452 + (rel + 224)] = tbl[bk * NH + h] * 1.4426950408889634f; }
          if (wave == 0) { const float s1 = wave_sum(args.in[I_LQ1][lane] * args.in[I_LK1][lane]), s2 = wave_sum(args.in[I_LQ2][lane] * args.in[I_LK2][lane]);
              if (lane == 0) lamp[0] = __expf(s1) - __expf(s2) + LAM_INIT; } }
        __syncthreads();
#pragma unroll 1
        for (int pi = 0; pi < 4; ++pi) {
            const int unit = vcu * 4 + pi;
            const int bh = unit >> 6, qb = unit & 63, b = bh >> 2, h = bh & 3, q0 = qb * att::QROWS;
            const size_t rowbase = (size_t)b * SEQ;
            f32x16 o[4]; float l;
            { const int t_ = opaque_tid(wave0), l_ = t_ & 63, w_ = t_ >> 6;
              const bf16* Qw = Qb + (rowbase + q0 + (w_ & 3) * 32 + (l_ & 31)) * 512 + h * 128 + (w_ >> 2) * 64 + (l_ >> 5) * 8;
              att::attn_pass(Qw, Kb + rowbase * 512 + h * 128, Vb + rowbase * 512 + h * 128, q0, al, tab + h * 452, o, l, wave0); }
            asm volatile("" ::: "memory");
            {
                const int t2_ = opaque_tid(wave0), ln = t2_ & 63, wv = __builtin_amdgcn_readfirstlane(t2_ >> 6), r32 = ln & 31, hi2 = ln >> 5, comp = wv >> 2, wq = wv & 3;
                LAS float* wsf = (LAS float*)(al + att::L_WS) + wv * 64;
                LAS float* xch = (LAS float*)(al + att::L_XCH) + wq * 4096 + ln;
                if (hi2 == 0) wsf[r32] = l; LDS_WAIT();
#pragma unroll
                for (int r = 0; r < 16; ++r) { const float rl = __builtin_amdgcn_rcpf(wsf[att::crow(r, hi2)]);
#pragma unroll
                    for (int d = 0; d < 4; ++d) o[d][r] *= rl; }
                if (comp == 1) {
#pragma unroll
                    for (int r = 0; r < 16; ++r) {
#pragma unroll
                        for (int d = 0; d < 4; ++d) xch[(d * 16 + r) * 64] = o[d][r]; }
                }
                __syncthreads();
                if (comp == 0) {
                    const float lam = lamp[0];
                    LAS bf16* st = (LAS bf16*)(al + att::L_STG) + wq * 4096;
#pragma unroll
                    for (int r = 0; r < 16; ++r) { float v[4]; float sq = 0.f;
#pragma unroll
                        for (int d = 0; d < 4; ++d) { v[d] = o[d][r] - lam * xch[(d * 16 + r) * 64]; sq += v[d] * v[d]; }
#pragma unroll
                        for (int off = 1; off < 32; off <<= 1) sq += __shfl_xor(sq, off);
                        const float rs = 1.0f / sqrtf(sq * (1.0f / 128.0f) + LN_EPS); const int orow = att::crow(r, hi2);
#pragma unroll
                        for (int d = 0; d < 4; ++d) st[orow * 128 + d * 32 + r32] = (bf16)(cvt_pk_bf16(v[d] * rs, 0.f) & 0xffffu); }
                    LDS_WAIT();
                    bf16* Ow = ON + (rowbase + q0 + wq * 32) * 512 + h * 128;
#pragma unroll
                    for (int i = 0; i < 8; ++i) { const int p = i * 64 + ln, row = p >> 4, chn = p & 15; const v4u vv = *(const LAS v4u*)(st + row * 128 + chn * 8); *(v4u*)(Ow + (size_t)row * 512 + chn * 8) = vv; }
                }
                __syncthreads();
            }
        }
    }
    SEAM(2);

    if (IN(3)) { PHASE_IDS
        { pg8::DenseOrder S; S.init(PL, WpT, M, DM, PW, G, bx, DUP(3)); pg8::EpiGate<false> E{Gb, 0, nullptr, Tb};
          pg8::gemm_phase<pg8::EpiGate<false>, pg8::DenseOrder, false>(lds + RING_OFF, PW, S, E, nullptr, wave0); }
        { pg8::DenseOrder S; S.init(ON, WaT, M, DM, AW, G, bx, DUP(3)); pg8::EpiGate<true> E{Gb, DM, Tb, MG};
          pg8::gemm_phase<pg8::EpiGate<true>, pg8::DenseOrder, false>(lds + RING_OFF, AW, S, E, nullptr, wave0); }
    }
    SEAM(3);

    if (IN(4)) { PHASE_IDS
        pg8::DenseOrder S; S.init(MG, WoT, M, DM, DM, G, bx, DUP(4)); pg8::EpiResid E{args.in[I_X], Z};
        pg8::gemm_phase<pg8::EpiResid, pg8::DenseOrder, false>(lds + RING_OFF, DM, S, E, nullptr, wave0);
    }
    SEAM(4);

    if (IN(5)) { PHASE_IDS
        const float* gma = args.in[I_LN1G]; const float* bta = args.in[I_LN1B];
        f32x4 gv[4], bv[4];
#pragma unroll
        for (int j = 0; j < 4; ++j) { gv[j] = *(const f32x4*)(gma + 4 * lane + 256 * j); bv[j] = *(const f32x4*)(bta + 4 * lane + 256 * j); }
        for (int m = gw; m < M; m += NGW) {
            const f32x4* xr = (const f32x4*)(Z + (size_t)m * DM) + lane; f32x4 v[4]; float s = 0.f;
#pragma unroll
            for (int j = 0; j < 4; ++j) { v[j] = xr[64 * j]; s += (v[j].x + v[j].y) + (v[j].z + v[j].w); }
            const float mean = wave_sum(s) * (1.f / DM); float s2 = 0.f;
#pragma unroll
            for (int j = 0; j < 4; ++j) { v[j] = v[j] - mean; s2 += (v[j].x * v[j].x + v[j].y * v[j].y) + (v[j].z * v[j].z + v[j].w * v[j].w); }
            const float rstd = 1.f / sqrtf(wave_sum(s2) * (1.f / DM) + LN_EPS);
            v2u* bo = (v2u*)(H1B + (size_t)m * DM) + lane;
#pragma unroll
            for (int j = 0; j < 4; ++j) { const f32x4 y = v[j] * rstd * gv[j] + bv[j]; v2u w; w.x = cvt_pk_bf16(y.x, y.y); w.y = cvt_pk_bf16(y.z, y.w); bo[64 * j] = w; }
        }
        if (bx == 0) { for (int i = tid; i < DM / 2; i += NWAVES * 64) ((unsigned*)(H1B + (size_t)M * DM))[i] = 0u; }
    }
    SEAM(5);

    if (IN(6)) { PHASE_IDS
        pg8::DenseOrder S; S.init(H1B, WrT, M, NE, DM, G, bx, DUP(6)); pg8::EpiLogits E{LOG};
        pg8::gemm_phase<pg8::EpiLogits, pg8::DenseOrder, false>(lds + RING_OFF, DM, S, E, nullptr, wave0);
    }
    SEAM(6);

    const int CH = M / G;
    if (IN(7)) { PHASE_IDS
        LAS int* hist = (LAS int*)(lds + RING_OFF);
        for (int i = tid; i < NE; i += NWAVES * 64) hist[i] = 0;
        __syncthreads();
        const f32x4 rb = *(const f32x4*)(args.in[I_RB] + 4 * lane);
        for (int tt = wave; tt < CH; tt += NWAVES) {
            const int t = bx * CH + tt;
            const f32x4 lg = *(const f32x4*)(LOG + (size_t)t * NE + 4 * lane);
            float s[4], c[4];
#pragma unroll
            for (int j = 0; j < 4; ++j) { s[j] = 1.0f / (1.0f + __expf(-lg[j])); c[j] = s[j] + rb[j]; }
            float m1 = fmaxf(c[0], c[1]), m2 = fminf(c[0], c[1]);
            { const float a = fmaxf(c[2], c[3]), b2 = fminf(c[2], c[3]); const float n1 = fmaxf(m1, a), n2 = fmaxf(fminf(m1, a), fmaxf(m2, b2)); m1 = n1; m2 = n2; }
#define TOP2_MERGE(CTRL) do { const float a1 = dpp_f<CTRL>(m1), a2 = dpp_f<CTRL>(m2); const float n1 = fmaxf(m1, a1), n2 = fmaxf(fminf(m1, a1), fmaxf(m2, a2)); m1 = n1; m2 = n2; } while (0)
            TOP2_MERGE(0xB1); TOP2_MERGE(0x4E); TOP2_MERGE(0x141);
#undef TOP2_MERGE
            const float gs = m1 + m2; const int mygrp = lane >> 3; int rank = 0;
#pragma unroll
            for (int g2 = 0; g2 < 8; ++g2) { const float og = readlane_f(gs, g2 * 8); rank += (og > gs || (og == gs && g2 < mygrp)) ? 1 : 0; }
            if (rank >= 4) {
#pragma unroll
                for (int j = 0; j < 4; ++j) c[j] = -INFINITY; }
            float wsel = 0.f; int isel = 0; float ssum = 0.f;
#pragma unroll 1
            for (int k = 0; k < TOPK; ++k) {
                float bv = c[0]; int bj = 0;
#pragma unroll
                for (int j = 1; j < 4; ++j) if (c[j] > bv) { bv = c[j]; bj = j; }
                const float mx = wave_max_f(bv);
                const unsigned long long msk = __ballot(bv == mx);
                const int wl = (int)__builtin_ctzll(msk);
                const int wj = __builtin_amdgcn_readlane(bj, wl);
                const float s01 = wj & 1 ? s[1] : s[0], s23 = wj & 1 ? s[3] : s[2];
                const float bs = readlane_f(wj & 2 ? s23 : s01, wl);
                if (lane == wl) {
#pragma unroll
                    for (int j = 0; j < 4; ++j) if (wj == j) c[j] = -INFINITY; }
                ssum += bs; if (lane == k) { wsel = bs; isel = wl * 4 + wj; }
            }
            if (lane < TOPK) { IDX[(size_t)t * TOPK + lane] = isel; TKW[(size_t)t * TOPK + lane] = wsel / ssum * ROUTED_SCALE; __hip_atomic_fetch_add(&hist[isel], 1, __ATOMIC_RELAXED, __HIP_MEMORY_SCOPE_WORKGROUP); }
        }
        __syncthreads();
        for (int i = tid; i < NE; i += NWAVES * 64) CNT[bx * NE + i] = hist[i];
        __syncthreads();
    }
    SEAM(7);

    LAS unsigned short* tile_e = (LAS unsigned short*)(lds + LT_TILE_E);
    LAS int* toks = (LAS int*)(lds + LT_TOKS);
    LAS int* ntr_p = (LAS int*)(lds + LT_NTR);
    if (IN(8)) { PHASE_IDS
        build_tables(lds, CNT, G, bx, tid);
        LAS int* tot = (LAS int*)(lds + RING_OFF); LAS int* before = tot + 256; LAS int* tstart = tot + 512; LAS int* lbase = tot + 768; LAS int* lcur = tot + 1024;
        const int NTr = ntr_p[0];
        if (tid < NE) { const int e = tid, ts = tstart[e], nt_ = (tot[e] + 255) >> 8; lbase[e] = ts * 256 + before[e]; lcur[e] = 0;
            if ((e % G) == bx) { for (int r = ts * 256 + tot[e]; r < (ts + nt_) * 256; ++r) { RTOK[r] = M; RW[r] = 0.f; RSLOT[r] = -1; } } }
        __syncthreads();
        for (int a = tid; a < CH * TOPK; a += NWAVES * 64) { const int t = bx * CH + a / TOPK; const int e = IDX[(size_t)bx * CH * TOPK + a]; const float w = TKW[(size_t)bx * CH * TOPK + a];
            const int p = __hip_atomic_fetch_add(&lcur[e], 1, __ATOMIC_RELAXED, __HIP_MEMORY_SCOPE_WORKGROUP); const int dest = lbase[e] + p; RTOK[dest] = t; RW[dest] = w; RSLOT[dest] = bx * CH * TOPK + a; }
        for (int i = tid; i < CH; i += NWAVES * 64) RTOK[NTr * 256 + bx * CH + i] = bx * CH + i;
        __syncthreads();
    }
    SEAM(8);

    if (IN(9)) { PHASE_IDS
        if (!IN(8)) build_tables(lds, CNT, G, bx, tid);
        const int NT = ntr_p[0] + M / 256;
        pg8::ExpertOrder<2, true> S{0, NT, G, vcu, tile_e, (const char*)H1B, (const char*)WguT, (size_t)512 * DM * 2, 0, (size_t)256 * DM * 2, DUP(9)};
        for (int j = 0; j < 8; ++j) { const int rt = S.local(j); if (rt >= 0) for (int i = tid; i < 256; i += NWAVES * 64) toks[j * 256 + i] = RTOK[rt * 256 + i]; }
        __syncthreads();
        pg8::EpiSwiglu E{HID};
        pg8::gemm_phase<pg8::EpiSwiglu, pg8::ExpertOrder<2, true>, true>(lds + RING_OFF, DM, S, E, toks, wave0);
    }
    SEAM(9);

    if (IN(10)) { PHASE_IDS
        if (!IN(8) && !IN(9)) build_tables(lds, CNT, G, bx, tid);
        const int NTr = ntr_p[0], NT = NTr + M / 256;
        { pg8::ExpertOrder<4, false> S{0, NTr, G, vcu, tile_e, (const char*)HID, (const char*)WdT, (size_t)DM * ED * 2, (size_t)256 * ED * 2, (size_t)256 * ED * 2, DUP(10)};
          LAS int* lslot = toks; LAS float* lw = (LAS float*)(lds + LT_ATT);
          for (int j = 0; j < 8; ++j) { const int rt = S.local(j); if (rt >= 0) for (int i = tid; i < 256; i += NWAVES * 64) { lslot[j * 256 + i] = RSLOT[rt * 256 + i]; lw[j * 256 + i] = RW[rt * 256 + i]; } }
          __syncthreads();
          pg8::EpiDownRouted E{OS, lslot, lw};
          pg8::gemm_phase<pg8::EpiDownRouted, pg8::ExpertOrder<4, false>, false>(lds + RING_OFF, ED, S, E, nullptr, wave0); }
        { pg8::ExpertOrder<4, false> S{NTr, NT, G, vcu, tile_e, (const char*)HID, (const char*)WdT, (size_t)DM * ED * 2, (size_t)256 * ED * 2, (size_t)256 * ED * 2, DUP(10)};
          pg8::EpiDownShared E{YSB, NTr * 256};
          pg8::gemm_phase<pg8::EpiDownShared, pg8::ExpertOrder<4, false>, false>(lds + RING_OFF, ED, S, E, nullptr, wave0); }
    }
    SEAM(10);

    if (IN(11)) { PHASE_IDS
        const float* gma = args.in[I_LN2G]; const float* bta = args.in[I_LN2B];
        f32x4 gv[4], bv[4];
#pragma unroll
        for (int j = 0; j < 4; ++j) { gv[j] = *(const f32x4*)(gma + 16 * lane + 4 * j); bv[j] = *(const f32x4*)(bta + 16 * lane + 4 * j); }
        unsigned bad = __hip_atomic_load(ctl + CW_BAR + XB_TMO, RLX_AGENT);
        typedef float f2_t __attribute__((ext_vector_type(2)));
        for (int t = gw; t < M; t += NGW) {
            f32x4 v[4];
            { const size_t o_ = (size_t)t * DM + 16 * lane; f32x4 h0, h1, h2, h3, y0, y1, y2, y3;
              pg8::unpack8(*(const v4u*)(H1B + o_), h0, h1); pg8::unpack8(*(const v4u*)(H1B + o_ + 8), h2, h3);
              pg8::unpack8(*(const v4u*)(YSB + o_), y0, y1); pg8::unpack8(*(const v4u*)(YSB + o_ + 8), y2, y3);
              v[0] = h0 * ALPHA + y0; v[1] = h1 * ALPHA + y1; v[2] = h2 * ALPHA + y2; v[3] = h3 * ALPHA + y3; }
            f32x4 r[4];
#pragma unroll
            for (int j = 0; j < 4; ++j) r[j] = (f32x4){0.f, 0.f, 0.f, 0.f};
#pragma unroll
            for (int k = 0; k < TOPK; ++k) { const v4u a = *(const v4u*)(OS + ((size_t)t * TOPK + k) * DM + 16 * lane);
                const unsigned wd[4] = {a.x, a.y, a.z, a.w};
#pragma unroll
                for (int j = 0; j < 4; ++j) { const f2_t lo = __builtin_amdgcn_cvt_pk_f32_fp8((int)wd[j], false), hi = __builtin_amdgcn_cvt_pk_f32_fp8((int)wd[j], true);
                    r[j] += (f32x4){lo.x, lo.y, hi.x, hi.y}; } }
#pragma unroll
            for (int j = 0; j < 4; ++j) v[j] += r[j] * (1.0f / OSCALE);
            float s = 0.f;
#pragma unroll
            for (int j = 0; j < 4; ++j) s += (v[j].x + v[j].y) + (v[j].z + v[j].w);
            const float mean = wave_sum(s) * (1.f / DM); float s2 = 0.f;
#pragma unroll
            for (int j = 0; j < 4; ++j) { v[j] = v[j] - mean; s2 += (v[j].x * v[j].x + v[j].y * v[j].y) + (v[j].z * v[j].z + v[j].w * v[j].w); }
            const float rstd = 1.f / sqrtf(wave_sum(s2) * (1.f / DM) + LN_EPS);
#pragma unroll
            for (int j = 0; j < 4; ++j) { f32x4 y = v[j] * rstd * gv[j] + bv[j]; if (bad) y = (f32x4){__builtin_nanf(""), __builtin_nanf(""), __builtin_nanf(""), __builtin_nanf("")};
                *(f32x4*)(args.out + (size_t)t * DM + 16 * lane + 4 * j) = y; }
        }
    }
#undef IN
#undef SEAM
}

#ifndef MK_N_LAUNCHES
#define MK_N_LAUNCHES 1
#endif
constexpr int N_PHASES = 12;
extern "C" void kernel_launch(void* const* d_in, const int* in_sizes, int n_in, void* d_out, int out_size, void* d_ws, size_t ws_size, hipStream_t stream) {
    static int grid = 0;
    if (grid == 0) {
        if (n_in != 26 || in_sizes[0] != M * DM || out_size != M * DM || ws_size < WS_END) { fprintf(stderr, "kernel_launch: unexpected shapes (n_in %d, in0 %d, out %d, ws %zu)\n", n_in, n_in > 0 ? in_sizes[0] : -1, out_size, ws_size); grid = -1; return; }
        int dev = 0, cus = 0, per_cu = 0;
        if (hipGetDevice(&dev) != hipSuccess || hipDeviceGetAttribute(&cus, hipDeviceAttributeMultiprocessorCount, dev) != hipSuccess) { grid = -1; return; }
        if (hipFuncSetAttribute((const void*)fwd_kernel, hipFuncAttributeMaxDynamicSharedMemorySize, LDS_BYTES) != hipSuccess) { fprintf(stderr, "kernel_launch: hipFuncSetAttribute failed\n"); grid = -1; return; }
        if (hipOccupancyMaxActiveBlocksPerMultiprocessor(&per_cu, (const void*)fwd_kernel, NWAVES * 64, LDS_BYTES) != hipSuccess || per_cu < 1) { fprintf(stderr, "kernel_launch: occupancy query says %d\n", per_cu); }
        (void)hipGetLastError();
        grid = cus > 256 ? 256 : cus;
        if (grid != 256) { fprintf(stderr, "kernel_launch: this build needs 256 CUs (got %d)\n", cus); grid = -1; return; }
    }
    if (grid < 0) return;
    (void)hipMemsetAsync((char*)d_ws + WS_CTL, 0, CTL_ZERO_BYTES, stream);
    Args a{};
    for (int i = 0; i < 26; ++i) a.in[i] = (const float*)d_in[i];
    a.out = (float*)d_out; a.ws = (unsigned char*)d_ws;
    if (MK_N_LAUNCHES == 1) { a.ph_lo = 0; a.ph_hi = N_PHASES; hipLaunchKernelGGL(fwd_kernel, dim3(grid), dim3(NWAVES * 64), LDS_BYTES, stream, a); }
    else { for (int p = 0; p < N_PHASES; ++p) { a.ph_lo = p; a.ph_hi = p + 1; hipLaunchKernelGGL(fwd_kernel, dim3(grid), dim3(NWAVES * 64), LDS_BYTES, stream, a); } }
    const hipError_t le = hipPeekAtLastError();
    if (le != hipSuccess) fprintf(stderr, "kernel_launch: launch failed: %s\n", hipGetErrorName(le));
}
```
